# Optimizing an MI355X kernel written in HIP

```python
import math
import jax, jax.numpy as jnp
from jax import lax
import numpy as np

D_MODEL = 4096
BATCH = 4
SEQ = 4096
DEPTH = 1

CONV_DIM = D_MODEL // 2
CONV_GROUPS = 16
CONV_WIDTH = 3
N_HEADS = 16
QK_NOPE_DIM = 128
QK_ROPE_DIM = 64
V_HEAD_DIM = 128
QK_HEAD_DIM = QK_NOPE_DIM + QK_ROPE_DIM
ATTN_DIM = N_HEADS * V_HEAD_DIM
Q_LORA_RANK = 1024
KV_LORA_RANK = 512
N_BRANCHES = 2
D_FF = ((8 * D_MODEL // 3 + 255) // 256) * 256
ROPE_THETA = 10000.0
RMS_EPS = 1e-6
Q_BLOCK = 128
SOFTMAX_SCALE = 1.0 / math.sqrt(QK_HEAD_DIM)

IN_SPLITS = (CONV_DIM, CONV_DIM, CONV_DIM, Q_LORA_RANK, KV_LORA_RANK, QK_ROPE_DIM,
             N_BRANCHES * D_MODEL)
IN_COLS = CONV_DIM * 3 + Q_LORA_RANK + KV_LORA_RANK + QK_ROPE_DIM + N_BRANCHES * D_MODEL

kernel_name = "hybrid_shortconv_mla_gated_encoder"


def split_columns(z, widths):
    parts = []
    start = 0
    for wdt in widths:
        parts.append(z[..., start:start + wdt])
        start += wdt
    return parts


def rms_norm(x, g):
    xf = x.astype(jnp.float32)
    inv = lax.rsqrt(jnp.mean(xf * xf, axis=-1, keepdims=True) + RMS_EPS)
    return (xf * inv * g.astype(jnp.float32)).astype(x.dtype)


def centred_short_conv(u, w):
    up = jnp.pad(u, ((0, 0), (1, 1), (0, 0)))
    return up[:, :-2] * w[0] + up[:, 1:-1] * w[1] + up[:, 2:] * w[2]


def rotary(t, cos, sin):
    half = t.shape[-1] // 2
    t1, t2 = t[..., :half], t[..., half:]
    return jnp.concatenate([t1 * cos - t2 * sin, t1 * sin + t2 * cos], axis=-1)


def mla_attention(q_nope, q_rope, k_nope, k_rope, v):
    b, s, h, _ = q_nope.shape
    nblk = s // Q_BLOCK

    def to_blocks(t):
        return jnp.swapaxes(t.reshape((b, nblk, Q_BLOCK) + t.shape[2:]), 0, 1)

    def block(qs):
        qn, qr = qs
        sc = jnp.einsum('bqhd,bkhd->bhqk', qn, k_nope).astype(jnp.float32)
        sc = sc + jnp.einsum('bqhr,bkr->bhqk', qr, k_rope).astype(jnp.float32)
        p = jax.nn.softmax(sc * SOFTMAX_SCALE, axis=-1).astype(v.dtype)
        return jnp.einsum('bhqk,bkhd->bqhd', p, v)

    out = lax.map(block, (to_blocks(q_nope), to_blocks(q_rope)))
    return jnp.swapaxes(out, 0, 1).reshape(b, s, h * V_HEAD_DIM)


def setup_inputs(seed: int = 0) -> dict:
    key = jax.random.key(seed)
    ks = jax.random.split(key, 20)

    def w(k, shape, fan_in):
        return jax.random.normal(k, shape, jnp.float32) * (fan_in ** -0.5)

    def gain(k, shape):
        return 1.0 + 0.02 * jax.random.normal(k, shape, jnp.float32)

    x = jax.random.normal(ks[0], (BATCH, SEQ, D_MODEL), jnp.float32)
    positions = (jnp.arange(SEQ, dtype=jnp.int32)[None, :]
                 + jax.random.randint(ks[1], (BATCH, 1), 0, 1024, dtype=jnp.int32))
    return {
        "x": x,
        "positions": positions,
        "g_mix": gain(ks[2], (DEPTH, D_MODEL)),
        "w_in": w(ks[3], (DEPTH, D_MODEL, IN_COLS), D_MODEL),
        "b_gate": 0.01 * jax.random.normal(ks[4], (DEPTH, N_BRANCHES * D_MODEL), jnp.float32),
        "conv_w": w(ks[5], (DEPTH, CONV_WIDTH, CONV_DIM), CONV_WIDTH),
        "g_q_a": gain(ks[6], (DEPTH, Q_LORA_RANK)),
        "w_q_b": w(ks[7], (DEPTH, Q_LORA_RANK, N_HEADS * QK_HEAD_DIM), Q_LORA_RANK),
        "g_kv_a": gain(ks[8], (DEPTH, KV_LORA_RANK)),
        "w_kv_b": w(ks[9], (DEPTH, KV_LORA_RANK, N_HEADS * (QK_NOPE_DIM + V_HEAD_DIM)), KV_LORA_RANK),
        "w_branch": w(ks[10], (DEPTH, N_BRANCHES, CONV_DIM, D_MODEL), CONV_DIM),
        "w_out": w(ks[11], (DEPTH, D_MODEL, D_MODEL), D_MODEL),
        "g_ffn": gain(ks[12], (DEPTH, D_MODEL)),
        "w_ffn_gate": w(ks[13], (DEPTH, D_MODEL, D_FF), D_MODEL),
        "w_ffn_up": w(ks[14], (DEPTH, D_MODEL, D_FF), D_MODEL),
        "w_ffn_down": w(ks[15], (DEPTH, D_FF, D_MODEL), D_FF),
        "g_final": gain(ks[16], (D_MODEL,)),
    }


def reference(x, positions, g_mix, w_in, b_gate, conv_w, g_q_a, w_q_b, g_kv_a, w_kv_b,
              w_branch, w_out, g_ffn, w_ffn_gate, w_ffn_up, w_ffn_down, g_final):
    b, s, d = x.shape
    dt = x.dtype
    inv_freq = ROPE_THETA ** (-jnp.arange(0, QK_ROPE_DIM, 2, dtype=jnp.float32) / QK_ROPE_DIM)
    ang = positions.astype(jnp.float32)[..., None] * inv_freq[None, None, :]
    cos, sin = jnp.cos(ang).astype(dt), jnp.sin(ang).astype(dt)

    for l in range(DEPTH):
        h = rms_norm(x, g_mix[l])
        z = h @ w_in[l]
        c_b, c_c, c_h, q_a, kv_a, k_rope, z_gate = split_columns(z, IN_SPLITS)

        y_a = c_b * centred_short_conv(c_c * c_h, conv_w[l])

        q = (rms_norm(q_a, g_q_a[l]) @ w_q_b[l]).reshape(b, s, N_HEADS, QK_HEAD_DIM)
        q_nope, q_rope = q[..., :QK_NOPE_DIM], q[..., QK_NOPE_DIM:]
        q_rope = rotary(q_rope, cos[:, :, None, :], sin[:, :, None, :])
        kv = (rms_norm(kv_a, g_kv_a[l]) @ w_kv_b[l]).reshape(b, s, N_HEADS, QK_NOPE_DIM + V_HEAD_DIM)
        k_nope, v = kv[..., :QK_NOPE_DIM], kv[..., QK_NOPE_DIM:]
        k_rope = rotary(k_rope, cos, sin)
        y_b = mla_attention(q_nope, q_rope, k_nope, k_rope, v)

        y_br = jnp.einsum('nbsc,ncd->bsnd', jnp.stack([y_a, y_b], axis=0), w_branch[l])
        gates = jax.nn.sigmoid((z_gate + b_gate[l]).astype(jnp.float32)).astype(dt)
        merged = jnp.sum(gates.reshape(b, s, N_BRANCHES, d) * y_br, axis=2)
        x = x + merged @ w_out[l]

        h2 = rms_norm(x, g_ffn[l])
        x = x + (jax.nn.silu(h2 @ w_ffn_gate[l]) * (h2 @ w_ffn_up[l])) @ w_ffn_down[l]

    return rms_norm(x, g_final)
```

```cpp
#include <hip/hip_runtime.h>
#include <hip/hip_bf16.h>
#include <cstdio>
#include <cstdint>

#ifndef PROBE_DUP
#define PROBE_DUP -1
#endif
#define DUP(k) (PROBE_DUP == (k) ? 2 : 1)
#ifndef MK_PER_PHASE
#define MK_PER_PHASE 0
#endif

namespace pg8 {
#define PG8_LAS __attribute__((address_space(3)))
typedef unsigned short bf16_t;
typedef short bf16x8 __attribute__((ext_vector_type(8)));
typedef float f32x4 __attribute__((ext_vector_type(4)));
typedef float f32x2 __attribute__((ext_vector_type(2)));
typedef unsigned u32x4 __attribute__((ext_vector_type(4)));
constexpr int BM = 256, BK = 64, HALF = 128, HTB = HALF * BK * 2, STAGE_BYTES = 8 * HTB, NXCD = 8, WGM = 8;

__host__ __device__ __forceinline__ int lds_byte(int r, int c) { const int st = (r >> 4) * 2 + (c >> 5), rr = r & 15, cc = c & 31, ob = rr * 64 + cc * 2; return st * 1024 + (ob ^ (((ob >> 9) & 1) << 5)); }
__host__ __device__ __forceinline__ void stage_rc(int b, int& R, int& C) { const int st = b / 1024, sb = b % 1024, swz = sb ^ (((sb >> 9) & 1) << 5); R = (st >> 1) * 16 + swz / 64; C = (st & 1) * 32 + (swz % 64) / 2; }
__host__ __device__ __forceinline__ int perm32(int rho) { const int n = rho >> 4, i = rho & 15; return 8 * (i >> 2) + 4 * n + (i & 3); }

struct Unit { int pm, pn; };
struct Gemm { const bf16_t* A; const bf16_t* Bt; int M, N, K, lda, ldb; };

struct StaticOrder {
    int nM, nN, nwg, G, c, wgm;
    __host__ __device__ void init(int M, int N, int G_, int c_, int wgm_ = WGM) { nM = M / BM; nN = N / BM; nwg = nM * nN; G = G_; c = c_; wgm = wgm_; }
    __host__ __device__ bool next(int i, Unit& u) const {
        const long L = (long)i * G + c; if (L >= nwg) return false;
        int wgid = (int)L; { const int q = nwg / NXCD, r = nwg % NXCD, xcd = wgid % NXCD, off = wgid / NXCD; wgid = (xcd < r ? xcd * (q + 1) : r * (q + 1) + (xcd - r) * q) + off; }
        const int nig = wgm * nN, gid = wgid / nig, fm = gid * wgm, gsz = (nM - fm) < wgm ? (nM - fm) : wgm;
        u.pm = fm + ((wgid % nig) % gsz); u.pn = (wgid % nig) / gsz; return true;
    }
    __device__ __forceinline__ void a_ready(const Unit&) const {}
    __device__ __forceinline__ void done(const Unit&) const {}
};

__device__ __forceinline__ unsigned cvt_pk_bf16(float lo, float hi) { unsigned r; asm volatile("v_cvt_pk_bf16_f32 %0, %1, %2" : "=v"(r) : "v"(lo), "v"(hi)); return r; }
__device__ __forceinline__ unsigned pk4_fp8(float a, float b, float c, float d) { int w = __builtin_amdgcn_cvt_pk_fp8_f32(a, b, 0, false); w = __builtin_amdgcn_cvt_pk_fp8_f32(c, d, w, true); return (unsigned)w; }
typedef unsigned u32x2 __attribute__((ext_vector_type(2)));
__device__ __forceinline__ float bf_lo(unsigned w) { return __uint_as_float(w << 16); }
__device__ __forceinline__ float bf_hi(unsigned w) { return __uint_as_float(w & 0xffff0000u); }
__device__ __forceinline__ float sigmoidf_fast(float v) { return __builtin_amdgcn_rcpf(1.0f + __expf(-v)); }

typedef f32x4 Acc[2][2][4][2];

__device__ __forceinline__ void store_tile_bf16(const Acc& acc, bf16_t* base, int ldc, int row0, int col0, float sc = 1.0f) {
#pragma unroll
    for (int ai = 0; ai < 2; ++ai)
#pragma unroll
        for (int m = 0; m < 4; ++m) { bf16_t* rowp = base + (size_t)(row0 + ai * HALF + m * 16) * ldc + col0;
#pragma unroll
            for (int bj = 0; bj < 2; ++bj) { const f32x4 v0 = acc[ai][bj][m][0] * sc, v1 = acc[ai][bj][m][1] * sc;
                u32x4 w; w.x = cvt_pk_bf16(v0[0], v0[1]); w.y = cvt_pk_bf16(v0[2], v0[3]); w.z = cvt_pk_bf16(v1[0], v1[1]); w.w = cvt_pk_bf16(v1[2], v1[3]);
                *(u32x4*)(rowp + bj * HALF) = w; } }
}

struct EpiZ {
    static constexpr bool PERM = true, HAS_MID = false; static constexpr int NST = 16;
    bf16_t *zc, *zs, *zg, *zr;
    __device__ __forceinline__ void operator()(const Acc& acc, const Unit& u, int wr, int wc, int fr, int fq) const {
        const int pn = u.pn; bf16_t* base; int ldc, colt;
        if (pn < 24) { base = zc; ldc = 6144; colt = pn * 256; }
        else if (pn < 30) { base = zs; ldc = 1536; colt = (pn - 24) * 256; }
        else { base = zr; ldc = 256; colt = 0; }
        store_tile_bf16(acc, base, ldc, u.pm * BM + wr * 64 + fr, colt + wc * 32 + 8 * fq);
    }
};
struct EpiG8 {
    static constexpr bool PERM = true, HAS_MID = false; static constexpr int NST = 16;
    unsigned char* zg; float sc;
    __device__ __forceinline__ void operator()(const Acc& acc, const Unit& u, int, int, int, int) const {
        int tz = threadIdx.x; asm volatile("" : "+v"(tz));
        const int wid_ = tz >> 6, lane_ = tz & 63, wr = wid_ >> 2, wc = wid_ & 3, fr = lane_ & 15, fq = lane_ >> 4;
        unsigned char* zb = zg + (size_t)(u.pm * BM + wr * 64 + fr) * 8192 + u.pn * 256 + wc * 32 + 8 * fq;
#pragma unroll
        for (int ai = 0; ai < 2; ++ai)
#pragma unroll
            for (int m = 0; m < 4; ++m)
#pragma unroll
                for (int bj = 0; bj < 2; ++bj) { const f32x4 v0 = acc[ai][bj][m][0] * sc, v1 = acc[ai][bj][m][1] * sc;
                    u32x2 w; w.x = pk4_fp8(v0[0], v0[1], v0[2], v0[3]); w.y = pk4_fp8(v1[0], v1[1], v1[2], v1[3]);
                    *(u32x2*)(zb + (size_t)(ai * HALF + m * 16) * 8192 + bj * HALF) = w; }
    }
};
struct EpiZ8 {
    static constexpr bool PERM = true, HAS_MID = false; static constexpr int NST = 16;
    bf16_t *zg, *zs, *zr; float sc;
    __device__ __forceinline__ void operator()(const Acc& acc, const Unit& u, int, int, int, int) const {
        int tz = threadIdx.x; asm volatile("" : "+v"(tz));
        const int wid_ = tz >> 6, lane_ = tz & 63, wr = wid_ >> 2, wc = wid_ & 3, fr = lane_ & 15, fq = lane_ >> 4;
        const int pn = u.pn; bf16_t* base; int ldc, colt;
        if (pn < 6) { base = zs; ldc = 1536; colt = pn * 256; }
        else { base = zr; ldc = 256; colt = 0; }
        store_tile_bf16(acc, base, ldc, u.pm * BM + wr * 64 + fr, colt + wc * 32 + 8 * fq, sc);
    }
};
struct EpiBf16 {
    static constexpr bool PERM = true, HAS_MID = false; static constexpr int NST = 16;
    bf16_t* O; int ldc; float sc;
    __device__ __forceinline__ void operator()(const Acc& acc, const Unit& u, int wr, int wc, int fr, int fq) const {
        store_tile_bf16(acc, O, ldc, u.pm * BM + wr * 64 + fr, u.pn * BM + wc * 32 + 8 * fq, sc);
    }
};
struct EpiQ {
    static constexpr bool PERM = true, HAS_MID = false; static constexpr int NST = 16;
    unsigned char* Q8; const float* cs; float sc;
    __device__ __forceinline__ void operator()(const Acc& acc, const Unit& u, int wr, int wc, int fr, int fq) const {
        const int row0 = u.pm * BM + wr * 64 + fr;
        if (u.pn < 8) {
#pragma unroll
            for (int ai = 0; ai < 2; ++ai)
#pragma unroll
                for (int m = 0; m < 4; ++m) { unsigned char* rowp = Q8 + (size_t)(row0 + ai * HALF + m * 16) * 3072 + wc * 32 + 8 * fq;
#pragma unroll
                    for (int bj = 0; bj < 2; ++bj) { const f32x4 v0 = acc[ai][bj][m][0] * sc, v1 = acc[ai][bj][m][1] * sc;
                        u32x2 w; w.x = pk4_fp8(v0[0], v0[1], v0[2], v0[3]); w.y = pk4_fp8(v1[0], v1[1], v1[2], v1[3]);
                        *(u32x2*)(rowp + (2 * u.pn + bj) * 192) = w; } }
            return; }
        const int head = 4 * (u.pn - 8) + wc, i0 = 8 * fq;
#pragma unroll
        for (int ai = 0; ai < 2; ++ai)
#pragma unroll
            for (int m = 0; m < 4; ++m) { const int row = row0 + ai * HALF + m * 16;
                const f32x4* cp = (const f32x4*)(cs + (size_t)row * 64 + i0 * 2);
                const f32x4 c01 = cp[0], c23 = cp[1], c45 = cp[2], c67 = cp[3];
                const f32x4 a0 = acc[ai][0][m][0] * sc, a1 = acc[ai][0][m][1] * sc, b0 = acc[ai][1][m][0] * sc, b1 = acc[ai][1][m][1] * sc;
                float o1[8], o2[8];
                o1[0] = a0[0] * c01[0] - b0[0] * c01[1]; o2[0] = a0[0] * c01[1] + b0[0] * c01[0];
                o1[1] = a0[1] * c01[2] - b0[1] * c01[3]; o2[1] = a0[1] * c01[3] + b0[1] * c01[2];
                o1[2] = a0[2] * c23[0] - b0[2] * c23[1]; o2[2] = a0[2] * c23[1] + b0[2] * c23[0];
                o1[3] = a0[3] * c23[2] - b0[3] * c23[3]; o2[3] = a0[3] * c23[3] + b0[3] * c23[2];
                o1[4] = a1[0] * c45[0] - b1[0] * c45[1]; o2[4] = a1[0] * c45[1] + b1[0] * c45[0];
                o1[5] = a1[1] * c45[2] - b1[1] * c45[3]; o2[5] = a1[1] * c45[3] + b1[1] * c45[2];
                o1[6] = a1[2] * c67[0] - b1[2] * c67[1]; o2[6] = a1[2] * c67[1] + b1[2] * c67[0];
                o1[7] = a1[3] * c67[2] - b1[3] * c67[3]; o2[7] = a1[3] * c67[3] + b1[3] * c67[2];
                u32x2 w1, w2;
                w1.x = pk4_fp8(o1[0], o1[1], o1[2], o1[3]); w1.y = pk4_fp8(o1[4], o1[5], o1[6], o1[7]);
                w2.x = pk4_fp8(o2[0], o2[1], o2[2], o2[3]); w2.y = pk4_fp8(o2[4], o2[5], o2[6], o2[7]);
                unsigned char* rowp = Q8 + (size_t)row * 3072 + head * 192 + 128 + i0;
                *(u32x2*)rowp = w1; *(u32x2*)(rowp + 32) = w2; }
    }
};
struct EpiKV {
    static constexpr bool PERM = true, HAS_MID = false; static constexpr int NST = 16;
    unsigned char* K8n; unsigned char* V8T; float sc;
    __device__ __forceinline__ void operator()(const Acc& acc, const Unit& u, int wr, int wc, int fr, int fq) const {
        const int row0 = u.pm * BM + wr * 64 + fr, c0 = wc * 32 + 8 * fq;
        const int q = fr & 3; const unsigned sel = (unsigned)q | ((unsigned)(4 + q) << 8) | 0x0c0c0000u;
        unsigned char* vt = V8T + ((size_t)(((u.pm >> 4) * 16 + u.pn) * 64 + (u.pm & 15) * 4 + wr) * 128 + c0 + q) * 64 + 4 * (fr >> 2);
#pragma unroll
        for (int ai = 0; ai < 2; ++ai)
#pragma unroll
            for (int m = 0; m < 4; ++m) { const size_t row = (size_t)(row0 + ai * HALF + m * 16);
                { const f32x4 v0 = acc[ai][0][m][0] * sc, v1 = acc[ai][0][m][1] * sc; u32x2 w; w.x = pk4_fp8(v0[0], v0[1], v0[2], v0[3]); w.y = pk4_fp8(v1[0], v1[1], v1[2], v1[3]);
                  *(u32x2*)(K8n + row * 2048 + u.pn * 128 + c0) = w; }
#pragma unroll
                for (int n = 0; n < 2; ++n) { const f32x4 v = acc[ai][1][m][n] * sc; const int W = (int)pk4_fp8(v[0], v[1], v[2], v[3]);
                    const unsigned x0 = (unsigned)__builtin_amdgcn_update_dpp(0, W, 0x00, 0xF, 0xF, true), x1 = (unsigned)__builtin_amdgcn_update_dpp(0, W, 0x55, 0xF, 0xF, true);
                    const unsigned x2 = (unsigned)__builtin_amdgcn_update_dpp(0, W, 0xAA, 0xF, 0xF, true), x3 = (unsigned)__builtin_amdgcn_update_dpp(0, W, 0xFF, 0xF, 0xF, true);
                    const unsigned t01 = __builtin_amdgcn_perm(x1, x0, sel), t23 = __builtin_amdgcn_perm(x3, x2, sel);
                    *(unsigned*)(vt + (size_t)(ai * 2) * (128 * 64) + (4 * n) * 64 + 16 * m) = __builtin_amdgcn_perm(t23, t01, 0x05040100u); } }
    }
};
struct EpiGate {
    static constexpr bool PERM = true, HAS_MID = true; static constexpr int NST = 8;
    static constexpr int KSW = 32;
    static constexpr float SB = 2048.0f;
    const unsigned char* zg; const float* bg; bf16_t* O;
#define F8(w, i) __builtin_amdgcn_cvt_f32_fp8((int)(w), i)
    __device__ __forceinline__ static float pre(float z, float b) { return fminf(fmaxf(z + b, -40.f), 40.f); }
    __device__ __forceinline__ static float ratio(float za, float ba, float zb, float bb) { return SB * (1.0f + __expf(-pre(zb, bb))) * __builtin_amdgcn_rcpf(1.0f + __expf(-pre(za, ba))); }
    __device__ __forceinline__ static float sg(float z, float b) { return (1.0f / SB) * __builtin_amdgcn_rcpf(1.0f + __expf(-pre(z, b))); }
    __device__ __forceinline__ void mid(Acc& acc, const Unit& u, int, int, int, int) const {
        int tz = threadIdx.x; asm volatile("" : "+v"(tz));
        const int wid_ = tz >> 6, lane_ = tz & 63, wr = wid_ >> 2, wc = wid_ & 3, fr = lane_ & 15, fq = lane_ >> 4;
        const int row0 = u.pm * BM + wr * 64 + fr, col0 = u.pn * BM + wc * 32 + 8 * fq;
#pragma unroll
        for (int bj = 0; bj < 2; ++bj) { const int col = col0 + bj * HALF;
            const f32x4 bA0 = *(const f32x4*)(bg + col), bA1 = *(const f32x4*)(bg + col + 4), bB0 = *(const f32x4*)(bg + 4096 + col), bB1 = *(const f32x4*)(bg + 4096 + col + 4);
#pragma unroll
            for (int ai = 0; ai < 2; ++ai) { u32x2 ga[4], gb[4];
#pragma unroll
                for (int m = 0; m < 4; ++m) { const unsigned char* rp = zg + (size_t)(row0 + ai * HALF + m * 16) * 8192 + col; ga[m] = *(const u32x2*)rp; gb[m] = *(const u32x2*)(rp + 4096); }
                asm volatile("s_waitcnt vmcnt(0)" ::: "memory");
#pragma unroll
                for (int m = 0; m < 4; ++m) { const u32x2 a = ga[m], b = gb[m]; f32x4 r0, r1;
                    r0[0] = ratio(F8(a.x, 0), bA0[0], F8(b.x, 0), bB0[0]); r0[1] = ratio(F8(a.x, 1), bA0[1], F8(b.x, 1), bB0[1]);
                    r0[2] = ratio(F8(a.x, 2), bA0[2], F8(b.x, 2), bB0[2]); r0[3] = ratio(F8(a.x, 3), bA0[3], F8(b.x, 3), bB0[3]);
                    r1[0] = ratio(F8(a.y, 0), bA1[0], F8(b.y, 0), bB1[0]); r1[1] = ratio(F8(a.y, 1), bA1[1], F8(b.y, 1), bB1[1]);
                    r1[2] = ratio(F8(a.y, 2), bA1[2], F8(b.y, 2), bB1[2]); r1[3] = ratio(F8(a.y, 3), bA1[3], F8(b.y, 3), bB1[3]);
                    acc[ai][bj][m][0] *= r0; acc[ai][bj][m][1] *= r1; }
                asm volatile("" ::: "memory"); }
            asm volatile("" ::: "memory"); }
    }
    __device__ __forceinline__ void operator()(const Acc& acc, const Unit& u, int wr, int wc, int fr, int fq) const {
        const int row0 = u.pm * BM + wr * 64 + fr, col0 = u.pn * BM + wc * 32 + 8 * fq;
#pragma unroll
        for (int bj = 0; bj < 2; ++bj) { const int col = col0 + bj * HALF;
            u32x2 gb[2][4];
#pragma unroll
            for (int ai = 0; ai < 2; ++ai)
#pragma unroll
                for (int m = 0; m < 4; ++m) gb[ai][m] = *(const u32x2*)(zg + (size_t)(row0 + ai * HALF + m * 16) * 8192 + 4096 + col);
            const f32x4 bB0 = *(const f32x4*)(bg + 4096 + col), bB1 = *(const f32x4*)(bg + 4096 + col + 4);
            asm volatile("s_waitcnt vmcnt(0)" ::: "memory");
#pragma unroll
            for (int ai = 0; ai < 2; ++ai)
#pragma unroll
                for (int m = 0; m < 4; ++m) { const size_t row = (size_t)(row0 + ai * HALF + m * 16); const u32x2 b = gb[ai][m];
                    const f32x4 v0 = acc[ai][bj][m][0], v1 = acc[ai][bj][m][1];
                    u32x4 w;
                    w.x = cvt_pk_bf16(v0[0] * sg(F8(b.x, 0), bB0[0]), v0[1] * sg(F8(b.x, 1), bB0[1]));
                    w.y = cvt_pk_bf16(v0[2] * sg(F8(b.x, 2), bB0[2]), v0[3] * sg(F8(b.x, 3), bB0[3]));
                    w.z = cvt_pk_bf16(v1[0] * sg(F8(b.y, 0), bB1[0]), v1[1] * sg(F8(b.y, 1), bB1[1]));
                    w.w = cvt_pk_bf16(v1[2] * sg(F8(b.y, 2), bB1[2]), v1[3] * sg(F8(b.y, 3), bB1[3]));
                    *(u32x4*)(O + row * 4096 + col) = w; } }
    }
};
struct EpiResF32 {
    static constexpr bool PERM = false, HAS_MID = false; static constexpr int NST = 8;
    const float* base; float* out; int ldc;
    __device__ __forceinline__ void operator()(const Acc& acc, const Unit& u, int wr, int wc, int fr, int fq) const {
        const int row0 = u.pm * BM + wr * 64 + fr, col0 = u.pn * BM + wc * 32 + 4 * fq;
#pragma unroll
        for (int ai = 0; ai < 2; ++ai) { f32x4 b[4][2][2];
#pragma unroll
            for (int m = 0; m < 4; ++m) { const size_t off = (size_t)(row0 + ai * HALF + m * 16) * ldc + col0;
#pragma unroll
                for (int bj = 0; bj < 2; ++bj)
#pragma unroll
                    for (int n = 0; n < 2; ++n) b[m][bj][n] = *(const f32x4*)(base + off + bj * HALF + n * 16); }
            asm volatile("" ::: "memory");
#pragma unroll
            for (int m = 0; m < 4; ++m) { const size_t off = (size_t)(row0 + ai * HALF + m * 16) * ldc + col0;
#pragma unroll
                for (int bj = 0; bj < 2; ++bj)
#pragma unroll
                    for (int n = 0; n < 2; ++n) *(f32x4*)(out + off + bj * HALF + n * 16) = b[m][bj][n] + acc[ai][bj][m][n]; }
            asm volatile("" ::: "memory"); }
    }
};
struct EpiRes1 {
    static constexpr bool PERM = true, HAS_MID = false; static constexpr int NST = 8;
    const float* base; bf16_t* xb; float* slots; int ldc;
    __device__ __forceinline__ void operator()(const Acc& acc, const Unit& u, int wr, int wc, int fr, int fq) const {
        const int row0 = u.pm * BM + wr * 64 + fr, col0 = u.pn * BM + wc * 32 + 8 * fq;
#pragma unroll
        for (int ai = 0; ai < 2; ++ai) { f32x4 b[4][2][2];
#pragma unroll
            for (int m = 0; m < 4; ++m) { const size_t off = (size_t)(row0 + ai * HALF + m * 16) * ldc + col0;
#pragma unroll
                for (int bj = 0; bj < 2; ++bj)
#pragma unroll
                    for (int n = 0; n < 2; ++n) b[m][bj][n] = *(const f32x4*)(base + off + bj * HALF + n * 4); }
            asm volatile("" ::: "memory");
#pragma unroll
            for (int m = 0; m < 4; ++m) { const int row = row0 + ai * HALF + m * 16; const size_t off = (size_t)row * ldc + col0; float ss = 0.f;
#pragma unroll
                for (int bj = 0; bj < 2; ++bj) { const f32x4 v0 = b[m][bj][0] + acc[ai][bj][m][0], v1 = b[m][bj][1] + acc[ai][bj][m][1];
                    ss += ((v0[0] * v0[0] + v0[1] * v0[1]) + (v0[2] * v0[2] + v0[3] * v0[3])) + ((v1[0] * v1[0] + v1[1] * v1[1]) + (v1[2] * v1[2] + v1[3] * v1[3]));
                    u32x4 w; w.x = cvt_pk_bf16(v0[0], v0[1]); w.y = cvt_pk_bf16(v0[2], v0[3]); w.z = cvt_pk_bf16(v1[0], v1[1]); w.w = cvt_pk_bf16(v1[2], v1[3]);
                    *(u32x4*)(xb + off + bj * HALF) = w; }
                ss += __shfl_xor(ss, 16); ss += __shfl_xor(ss, 32);
                if (fq == 0) slots[(size_t)row * 64 + 4 * u.pn + wc] = ss; }
            asm volatile("" ::: "memory"); }
    }
};
struct EpiResB {
    static constexpr bool PERM = true, HAS_MID = false; static constexpr int NST = 16;
    bf16_t* xb; int ldc;
    __device__ __forceinline__ void operator()(const Acc& acc, const Unit& u, int wr, int wc, int fr, int fq) const {
        const int row0 = u.pm * BM + wr * 64 + fr, col0 = u.pn * BM + wc * 32 + 8 * fq;
        u32x4 b[2][4][2];
#pragma unroll
        for (int ai = 0; ai < 2; ++ai)
#pragma unroll
            for (int m = 0; m < 4; ++m)
#pragma unroll
                for (int bj = 0; bj < 2; ++bj) b[ai][m][bj] = *(const u32x4*)(xb + (size_t)(row0 + ai * HALF + m * 16) * ldc + col0 + bj * HALF);
        asm volatile("" ::: "memory");
#pragma unroll
        for (int ai = 0; ai < 2; ++ai)
#pragma unroll
            for (int m = 0; m < 4; ++m)
#pragma unroll
                for (int bj = 0; bj < 2; ++bj) { const u32x4 x = b[ai][m][bj]; const f32x4 v0 = acc[ai][bj][m][0], v1 = acc[ai][bj][m][1];
                    u32x4 w; w.x = cvt_pk_bf16(bf_lo(x.x) + v0[0], bf_hi(x.x) + v0[1]); w.y = cvt_pk_bf16(bf_lo(x.y) + v0[2], bf_hi(x.y) + v0[3]);
                    w.z = cvt_pk_bf16(bf_lo(x.z) + v1[0], bf_hi(x.z) + v1[1]); w.w = cvt_pk_bf16(bf_lo(x.w) + v1[2], bf_hi(x.w) + v1[3]);
                    *(u32x4*)(xb + (size_t)(row0 + ai * HALF + m * 16) * ldc + col0 + bj * HALF) = w; }
    }
};
struct EpiSwiGLU {
    static constexpr bool PERM = true, HAS_MID = false; static constexpr int NST = 8;
    bf16_t* O; int ldc; const float* inv;
    __device__ __forceinline__ static float sw(float g, float u) { return g * __builtin_amdgcn_rcpf(1.0f + __expf(-g)) * u; }
    __device__ __forceinline__ void operator()(const Acc& acc, const Unit& u, int wr, int wc, int fr, int fq) const {
        const int row0 = u.pm * BM + wr * 64 + fr, col0 = u.pn * HALF + wc * 32 + 8 * fq;
        float ivs[2][4];
#pragma unroll
        for (int ai = 0; ai < 2; ++ai)
#pragma unroll
            for (int m = 0; m < 4; ++m) ivs[ai][m] = inv[row0 + ai * HALF + m * 16];
        asm volatile("s_waitcnt vmcnt(0)" ::: "memory");
#pragma unroll
        for (int ai = 0; ai < 2; ++ai)
#pragma unroll
            for (int m = 0; m < 4; ++m) { const float iv = ivs[ai][m];
                const f32x4 g0 = acc[ai][0][m][0] * iv, g1 = acc[ai][0][m][1] * iv, u0 = acc[ai][1][m][0] * iv, u1 = acc[ai][1][m][1] * iv;
                u32x4 w;
                w.x = cvt_pk_bf16(sw(g0[0], u0[0]), sw(g0[1], u0[1])); w.y = cvt_pk_bf16(sw(g0[2], u0[2]), sw(g0[3], u0[3]));
                w.z = cvt_pk_bf16(sw(g1[0], u1[0]), sw(g1[1], u1[1])); w.w = cvt_pk_bf16(sw(g1[2], u1[2]), sw(g1[3], u1[3]));
                *(u32x4*)(O + (size_t)(row0 + ai * HALF + m * 16) * ldc + col0) = w; }
    }
};

template <class Epi, class Sched, bool ALIGN_EPI = false, bool SP2 = false, bool RELAX = true, bool FP8 = false, bool MIXED = false, bool SC = false>
__device__ __forceinline__ void gemm_phase(PG8_LAS unsigned char* lds, const Gemm g, const Sched& S, const Epi& E) {
    int tid_ = threadIdx.x; asm volatile("" : "+v"(tid_));
    const int tid = tid_, wid = __builtin_amdgcn_readfirstlane(tid >> 6), lane = tid & 63, wr = wid >> 2, wc = wid & 3, fr = lane & 15, fq = lane >> 4;
    const int K = g.K, nt = K / BK; int tmid = nt / 2; if constexpr (MIXED) tmid = Epi::KSW;
    unsigned voffA, voffB;
    { int R, C; stage_rc(tid * 16, R, C); const int Rb = Epi::PERM ? ((R & ~31) + perm32(R & 31)) : R;
      voffA = (unsigned)(R * g.lda + C) * 2u; voffB = (unsigned)(Rb * g.ldb + C) * 2u; }
    const size_t d64A = (size_t)64 * g.lda * 2, d64B = (size_t)64 * g.ldb * 2;
    const size_t kstep = (size_t)(BK * 2);
    const size_t hsA = (size_t)HALF * g.lda * 2, hsB = (size_t)HALF * g.ldb * 2;
    const size_t tsA = 2 * hsA, tsB = 2 * hsB;
    const unsigned ldsw = (unsigned)wid * 1024u;
    const int aoff = lds_byte(wr * 64 + fr, fq * 8), boff = lds_byte(wc * 32 + fr, fq * 8);
#define PG8_SA(b, h) (((b) * 2 + (h)) * HTB)
#define PG8_SB(b, h) ((4 + (b) * 2 + (h)) * HTB)
#define PG8_STAGE(bufoff, gbase, X) do { _Pragma("unroll") for (int _i = 0; _i < 2; ++_i) \
        __builtin_amdgcn_global_load_lds((const unsigned*)((const char*)(gbase) + _i * d64##X + voff##X), (PG8_LAS unsigned*)(lds + (bufoff) + ldsw + _i * 8192), 16, 0, 0); } while (0)
#define PG8_LDA(dst, b, h) do { _Pragma("unroll") for (int m = 0; m < 4; ++m) _Pragma("unroll") for (int k = 0; k < 2; ++k) dst[m][k] = *(const PG8_LAS bf16x8*)(lds + PG8_SA(b, h) + aoff + m * 2048 + k * 1024); } while (0)
#define PG8_LDB(dst, b, h) do { _Pragma("unroll") for (int n = 0; n < 2; ++n) _Pragma("unroll") for (int k = 0; k < 2; ++k) dst[n][k] = *(const PG8_LAS bf16x8*)(lds + PG8_SB(b, h) + boff + n * 2048 + k * 1024); } while (0)
    typedef long l64x2 __attribute__((ext_vector_type(2)));
    typedef int i32x4 __attribute__((ext_vector_type(4))); typedef int i32x8 __attribute__((ext_vector_type(8)));
#define PG8_MMA(ai, bj, At, Bt, F8) do { __builtin_amdgcn_s_setprio(1); \
        if constexpr (!(F8)) { _Pragma("unroll") for (int k = 0; k < 2; ++k) _Pragma("unroll") for (int m = 0; m < 4; ++m) _Pragma("unroll") for (int n = 0; n < 2; ++n) \
            acc[ai][bj][m][n] = __builtin_amdgcn_mfma_f32_16x16x32_bf16(Bt[n][k], At[m][k], acc[ai][bj][m][n], 0, 0, 0); } \
        else if constexpr (!SC) { _Pragma("unroll") for (int k = 0; k < 2; ++k) _Pragma("unroll") for (int hh = 0; hh < 2; ++hh) _Pragma("unroll") for (int m = 0; m < 4; ++m) _Pragma("unroll") for (int n = 0; n < 2; ++n) \
            acc[ai][bj][m][n] = __builtin_amdgcn_mfma_f32_16x16x32_fp8_fp8(__builtin_bit_cast(l64x2, Bt[n][k])[hh], __builtin_bit_cast(l64x2, At[m][k])[hh], acc[ai][bj][m][n], 0, 0, 0); } \
        else { _Pragma("unroll") for (int m = 0; m < 4; ++m) _Pragma("unroll") for (int n = 0; n < 2; ++n) { \
            const i32x8 b8_ = __builtin_shufflevector(__builtin_bit_cast(i32x4, Bt[n][0]), __builtin_bit_cast(i32x4, Bt[n][1]), 0, 1, 2, 3, 4, 5, 6, 7); \
            const i32x8 a8_ = __builtin_shufflevector(__builtin_bit_cast(i32x4, At[m][0]), __builtin_bit_cast(i32x4, At[m][1]), 0, 1, 2, 3, 4, 5, 6, 7); \
            acc[ai][bj][m][n] = __builtin_amdgcn_mfma_scale_f32_16x16x128_f8f6f4(b8_, a8_, acc[ai][bj][m][n], 0, 0, 0, 0, 0, 0); } } \
        __builtin_amdgcn_s_setprio(0); } while (0)
#define PG8_WAIT_V(n) asm volatile("s_waitcnt vmcnt(" #n ")" ::: "memory")
#define PG8_WAIT_L(n) asm volatile("s_waitcnt lgkmcnt(" #n ")" ::: "memory")
#define PG8_BAR __builtin_amdgcn_s_barrier()
#define PG8_SCHED __builtin_amdgcn_sched_barrier(0)
    Unit cur, nxt; int ui = 0;
    if (!S.next(0, cur)) return;
    Acc acc;
#pragma unroll
    for (int a = 0; a < 2; ++a)
#pragma unroll
        for (int b = 0; b < 2; ++b)
#pragma unroll
            for (int m = 0; m < 4; ++m)
#pragma unroll
                for (int n = 0; n < 2; ++n) acc[a][b][m][n] = (f32x4){0.f, 0.f, 0.f, 0.f};
    bf16x8 At[4][2], B0[2][2], B1[2][2];
    const char* cA = (const char*)g.A + (size_t)cur.pm * tsA; const char* cB = (const char*)g.Bt + (size_t)cur.pn * tsB;
    S.a_ready(cur);
    if constexpr (SP2) {
        PG8_STAGE(PG8_SB(0, 0), cB, B); PG8_STAGE(PG8_SB(0, 1), cB + hsB, B); PG8_STAGE(PG8_SA(0, 0), cA, A); PG8_STAGE(PG8_SA(0, 1), cA + hsA, A);
        if (wr == 1) PG8_BAR;
        PG8_WAIT_V(2); PG8_BAR;
        PG8_STAGE(PG8_SB(1, 0), cB + kstep, B); PG8_STAGE(PG8_SA(1, 0), cA + kstep, A); PG8_STAGE(PG8_SB(1, 1), cB + hsB + kstep, B);
        PG8_WAIT_V(0); PG8_BAR;
    } else {
        PG8_STAGE(PG8_SB(0, 0), cB, B); PG8_STAGE(PG8_SA(0, 0), cA, A); PG8_STAGE(PG8_SB(0, 1), cB + hsB, B); PG8_STAGE(PG8_SA(0, 1), cA + hsA, A);
        if (wr == 1) PG8_BAR;
        PG8_WAIT_V(4); PG8_BAR;
        PG8_STAGE(PG8_SB(1, 0), cB + kstep, B); PG8_STAGE(PG8_SA(1, 0), cA + kstep, A); PG8_STAGE(PG8_SB(1, 1), cB + hsB + kstep, B);
        PG8_WAIT_V(6); PG8_BAR;
    }
    for (;;) {
        const bool has_next = S.next(ui + 1, nxt);
        const char* nA = has_next ? (const char*)g.A + (size_t)nxt.pm * tsA : cA; const char* nB = has_next ? (const char*)g.Bt + (size_t)nxt.pn * tsB : cB;
        static_assert(SP2, "only the two-blocks-per-barrier K-loop is kept");
#define PG8_TRIP(T, WV, F8) do { const int t = (T); const bool last = (t == nt - 2); \
            const char* a1 = cA + (size_t)(t + 1) * kstep; \
            const char* a2 = last ? nA : cA + (size_t)(t + 2) * kstep; const char* b2 = last ? nB : cB + (size_t)(t + 2) * kstep; \
            const char* a3 = a2 + kstep; const char* b3 = b2 + kstep; \
            if (last && has_next) S.a_ready(nxt); \
            if constexpr (Epi::HAS_MID) { if (t == tmid) E.mid(acc, cur, wr, wc, fr, fq); } \
            PG8_LDB(B0, 0, 0); PG8_LDB(B1, 0, 1); PG8_SCHED; PG8_LDA(At, 0, 0); PG8_STAGE(PG8_SA(1, 1), a1 + hsA, A); \
            asm volatile("s_waitcnt vmcnt(%0)" :: "n"(WV) : "memory"); PG8_WAIT_L(0); PG8_BAR; PG8_MMA(0, 0, At, B0, F8); PG8_MMA(0, 1, At, B1, F8); PG8_BAR; PG8_SCHED; \
            PG8_LDA(At, 0, 1); PG8_STAGE(PG8_SB(0, 0), b2, B); PG8_STAGE(PG8_SB(0, 1), b2 + hsB, B); PG8_STAGE(PG8_SA(0, 0), a2, A); \
            asm volatile("s_waitcnt vmcnt(%0)" :: "n"(WV) : "memory"); PG8_WAIT_L(0); PG8_BAR; PG8_MMA(1, 0, At, B0, F8); PG8_MMA(1, 1, At, B1, F8); PG8_BAR; PG8_SCHED; \
            PG8_LDB(B0, 1, 0); PG8_LDB(B1, 1, 1); PG8_SCHED; PG8_LDA(At, 1, 0); PG8_STAGE(PG8_SA(0, 1), a2 + hsA, A); \
            PG8_WAIT_V(8); PG8_WAIT_L(0); PG8_BAR; PG8_MMA(0, 0, At, B0, F8); PG8_MMA(0, 1, At, B1, F8); PG8_BAR; PG8_SCHED; \
            PG8_LDA(At, 1, 1); PG8_STAGE(PG8_SB(1, 0), b3, B); PG8_STAGE(PG8_SB(1, 1), b3 + hsB, B); PG8_STAGE(PG8_SA(1, 0), a3, A); \
            PG8_WAIT_V(8); PG8_WAIT_L(0); PG8_BAR; PG8_MMA(1, 0, At, B0, F8); PG8_MMA(1, 1, At, B1, F8); PG8_BAR; PG8_SCHED; } while (0)
        if constexpr (MIXED) { static_assert(!RELAX && !FP8, "mixed K-loop: plain waits"); for (int tt = 0; tt < Epi::KSW; tt += 2) PG8_TRIP(tt, 8, false); for (int tt = Epi::KSW; tt < nt; tt += 2) PG8_TRIP(tt, 8, true); }
        else if constexpr (RELAX) { PG8_TRIP(0, 8 + Epi::NST, FP8); for (int tt = 2; tt < nt; tt += 2) PG8_TRIP(tt, 8, FP8); }
        else { for (int tt = 0; tt < nt; tt += 2) PG8_TRIP(tt, 8, FP8); }
#undef PG8_TRIP
        if constexpr (ALIGN_EPI) { if (wr == 0) PG8_BAR; }
        E(acc, cur, wr, wc, fr, fq); S.done(cur);
        if (!has_next) break;
#pragma unroll
        for (int a = 0; a < 2; ++a)
#pragma unroll
            for (int b = 0; b < 2; ++b)
#pragma unroll
                for (int m = 0; m < 4; ++m)
#pragma unroll
                    for (int n = 0; n < 2; ++n) acc[a][b][m][n] = (f32x4){0.f, 0.f, 0.f, 0.f};
        cur = nxt; cA = nA; cB = nB; ++ui;
        if constexpr (ALIGN_EPI) { if (wr == 1) PG8_BAR; }
    }
    PG8_WAIT_V(0);
    if constexpr (!ALIGN_EPI) { if (wr == 0) PG8_BAR; }
    PG8_BAR;
#undef PG8_SA
#undef PG8_SB
#undef PG8_STAGE
#undef PG8_LDA
#undef PG8_LDB
#undef PG8_MMA
#undef PG8_WAIT_V
#undef PG8_WAIT_L
#undef PG8_BAR
#undef PG8_SCHED
}
}

namespace mla {
using bf16x8 = __attribute__((ext_vector_type(8))) short;
using s16x4  = __attribute__((ext_vector_type(4))) short;
using f32x16 = __attribute__((ext_vector_type(16))) float;
using u32x4  = __attribute__((ext_vector_type(4))) unsigned;
typedef unsigned short bf16_t;
using u32x2 = __attribute__((ext_vector_type(2))) unsigned;
constexpr int NW = 8, QBLK = 32, KVBLK = 64;
constexpr float SCALE = 0.07216878364870323f;
constexpr float THR = 4.f;
constexpr float PLOG2 = 3.f;
constexpr int SDEPTH = 1;
constexpr int KROW = 200;
constexpr int VROW = 72;
constexpr int SHM_V = 128 * VROW, SHM_K = KVBLK * KROW, NVB = 3, SHM_ATTN = NVB * SHM_V + 2 * SHM_K + NW * 64 * 4;
static_assert(SHM_ATTN <= 131072, "attention LDS fits the ring region");
constexpr int LDQ8 = 3072, LDK8 = 2048, LDKR8 = 64, LDKV = 4096, LDO = 8192;
constexpr float OSC = 64.0f;
#define MLA_KSWZ(row, colB) ((row) * 384 + ((colB) ^ ((((row) >> 1) & 7) << 4)))
#define MLA_SBAR() __builtin_amdgcn_sched_barrier(0)
#define MLA_SBM() __builtin_amdgcn_sched_barrier(0x406)
__device__ __forceinline__ int crow(int r, int hi) { return (r & 3) + 8 * (r >> 2) + 4 * hi; }
__device__ __forceinline__ unsigned cvtpk(float lo, float hi) { unsigned r; asm volatile("v_cvt_pk_bf16_f32 %0, %1, %2" : "=v"(r) : "v"(lo), "v"(hi)); return r; }
__device__ __forceinline__ bf16x8 ld8(const bf16_t* p) { return *reinterpret_cast<const bf16x8*>(p); }

constexpr float THR_L2 = THR * 1.4426950408889634f;
template <bool FIRST> __device__ __forceinline__ void partialSM(f32x16& p0, f32x16& p1, f32x16& mneg, float& alpha) {
  float pmax = p0[0];
#pragma unroll
  for (int r = 1; r < 16; ++r) pmax = fmaxf(pmax, p0[r]);
#pragma unroll
  for (int r = 0; r < 16; ++r) pmax = fmaxf(pmax, p1[r]);
  { auto rr = __builtin_amdgcn_permlane32_swap(__float_as_uint(pmax), __float_as_uint(pmax), false, false);
    pmax = fmaxf(__uint_as_float(rr[0]), __uint_as_float(rr[1])); }
  float delta = pmax - PLOG2;
  if (!FIRST && __builtin_expect(__all(delta <= THR_L2), 1)) { alpha = 1.f; }
  else { if (!FIRST) delta = fmaxf(delta, 0.f);
    alpha = __builtin_amdgcn_exp2f(-delta);
#pragma unroll
    for (int r = 0; r < 16; ++r) { p0[r] -= delta; p1[r] -= delta; mneg[r] -= delta; } }
#pragma unroll
  for (int r = 0; r < 16; ++r) p0[r] = __builtin_amdgcn_exp2f(p0[r]);
}
__device__ __forceinline__ void finishSM(f32x16& p0, f32x16& p1, float alpha, float& l_reg, long& pa0, long& pa1, long& pa2, long& pa3) {
#pragma unroll
  for (int r = 0; r < 16; ++r) p1[r] = __builtin_amdgcn_exp2f(p1[r]);
  float ps = 0;
#pragma unroll
  for (int r = 0; r < 16; ++r) ps += p0[r];
#pragma unroll
  for (int r = 0; r < 16; ++r) ps += p1[r];
  { auto rr = __builtin_amdgcn_permlane32_swap(__float_as_uint(ps), __float_as_uint(ps), false, false);
    ps = __uint_as_float(rr[0]) + __uint_as_float(rr[1]); }
  l_reg = l_reg * alpha + ps;
#define MLA_PK4(P, BASE, OUT) do { const unsigned a_ = pg8::pk4_fp8(P[BASE + 0], P[BASE + 1], P[BASE + 2], P[BASE + 3]), b_ = pg8::pk4_fp8(P[BASE + 4], P[BASE + 5], P[BASE + 6], P[BASE + 7]); \
    auto r_ = __builtin_amdgcn_permlane32_swap(a_, b_, false, false); OUT = (long)(((unsigned long long)r_[1] << 32) | (unsigned long long)r_[0]); } while (0)
  MLA_PK4(p0, 0, pa0); MLA_PK4(p0, 8, pa1); MLA_PK4(p1, 0, pa2); MLA_PK4(p1, 8, pa3);
#undef MLA_PK4
}
#define MLA_LDV(addr) (*reinterpret_cast<const volatile __attribute__((address_space(3))) long*>((uintptr_t)(unsigned)(addr)))
typedef long l64x4 __attribute__((ext_vector_type(4))); typedef int i32x8 __attribute__((ext_vector_type(8)));
#define MLA_MMA64(a4, b4, c) __builtin_amdgcn_mfma_scale_f32_32x32x64_f8f6f4(__builtin_bit_cast(i32x8, a4), __builtin_bit_cast(i32x8, b4), c, 0, 0, 0, 0, 0, 0)
struct VFrag { l64x4 v; };
template <int D0> __device__ __forceinline__ void pv_read(VFrag& f, int vb) {
  f.v[0] = MLA_LDV(vb + D0 * 32 * VROW); f.v[1] = MLA_LDV(vb + D0 * 32 * VROW + 16); f.v[2] = MLA_LDV(vb + D0 * 32 * VROW + 32); f.v[3] = MLA_LDV(vb + D0 * 32 * VROW + 48);
}
#define MLA_KLD(T, s_, rb) do { T[0] = MLA_LDV(kb + BUFOFF + (rb) * 32 * KROW + (4 * (s_)) * 16); T[1] = MLA_LDV(kb + BUFOFF + (rb) * 32 * KROW + (4 * (s_) + 1) * 16); \
    T[2] = MLA_LDV(kb + BUFOFF + (rb) * 32 * KROW + (4 * (s_) + 2) * 16); T[3] = MLA_LDV(kb + BUFOFF + (rb) * 32 * KROW + (4 * (s_) + 3) * 16); } while (0)
template <int BUFOFF, bool PFV> __device__ __forceinline__ void qkt(f32x16& p0, f32x16& p1, const f32x16& mneg, int kb, const l64x4* qv, VFrag& fa, VFrag& fb, int vb) {
  l64x4 t0, t1, t2;
  MLA_KLD(t0, 0, 0); MLA_KLD(t1, 0, 1); MLA_KLD(t2, 1, 0);
  p0 = MLA_MMA64(t0, qv[0], mneg); MLA_SBM(); MLA_KLD(t0, 1, 1);
  p1 = MLA_MMA64(t1, qv[0], mneg); MLA_SBM(); MLA_KLD(t1, 2, 0);
  p0 = MLA_MMA64(t2, qv[1], p0); MLA_SBM(); MLA_KLD(t2, 2, 1);
  p1 = MLA_MMA64(t0, qv[1], p1); MLA_SBM(); if constexpr (PFV) pv_read<0>(fa, vb);
  p0 = MLA_MMA64(t1, qv[2], p0); MLA_SBM(); if constexpr (PFV) pv_read<1>(fb, vb);
  p1 = MLA_MMA64(t2, qv[2], p1); MLA_SBM();
}
#undef MLA_KLD
__device__ __forceinline__ void pv_mma(f32x16& od, const VFrag& f, long pa0, long pa1, long pa2, long pa3) {
  const l64x4 pa = {pa0, pa1, pa2, pa3};
  od = MLA_MMA64(pa, f.v, od);
}
__device__ __forceinline__ void pv_d0_pre(f32x16* o, int vb, long pa0, long pa1, long pa2, long pa3, VFrag& fa, VFrag& fb) {
  pv_mma(o[0], fa, pa0, pa1, pa2, pa3); MLA_SBM();
  pv_read<2>(fa, vb);
  pv_mma(o[1], fb, pa0, pa1, pa2, pa3); MLA_SBM();
  pv_read<3>(fb, vb);
  pv_mma(o[2], fa, pa0, pa1, pa2, pa3); MLA_SBM();
  pv_mma(o[3], fb, pa0, pa1, pa2, pa3);
}
__device__ __forceinline__ void pv_d0(f32x16* o, int vb, long pa0, long pa1, long pa2, long pa3) {
  VFrag fa, fb;
  pv_read<0>(fa, vb); pv_read<1>(fb, vb);
  pv_d0_pre(o, vb, pa0, pa1, pa2, pa3, fa, fb);
}
#define MLA_PIN2(a, b) asm volatile("" : "+v"(a), "+v"(b))

__device__ __forceinline__ void attn_unit(const unsigned char* __restrict__ Q8, const unsigned char* __restrict__ K8, const unsigned char* __restrict__ Kr8,
                                          const unsigned char* __restrict__ Vh, unsigned char* __restrict__ Ob, int seq, char* lds) {
  const int tid = threadIdx.x, wid = tid >> 6, lane = tid & 63, r32 = lane & 31, hi = lane >> 5;
  char* V_lds = lds; char* K_lds = lds + NVB * SHM_V;
  float* ws = (float*)(lds + NVB * SHM_V + 2 * SHM_K) + wid * 64; float* li_l = ws; float* al_l = ws + 32;
  float l_reg = 0; f32x16 o[4] = {}; l64x4 qv[3]; f32x16 mneg;
#pragma unroll
  for (int r = 0; r < 16; ++r) mneg[r] = PLOG2;
  { int tq = threadIdx.x; asm volatile("" : "+v"(tq));
    const unsigned qoff = (unsigned)((tq >> 6) * QBLK + (tq & 31)) * (unsigned)LDQ8 + (unsigned)(((tq >> 5) & 1) * 8);
    const unsigned char* qp = Q8 + qoff;
#pragma unroll
    for (int d0 = 0; d0 < 12; ++d0) qv[d0 >> 2][d0 & 3] = *(const long*)(qp + d0 * 16); }
  const int vst = (tid >> 2) * VROW + (tid & 3) * 16;
  const int kr = tid >> 3, kc = tid & 7;
  const int kst = kr * KROW + kc * 16, rst = kr * KROW + 128 + kc * 8;
  const int vb0 = (int)(uintptr_t)V_lds + r32 * VROW + hi * 8;
  const int kb = (int)(uintptr_t)K_lds + r32 * KROW + hi * 8;
  struct { u32x4 vs; u32x4 kn; long krp; } sr_[SDEPTH];
  const unsigned offV = (unsigned)tid * 16u, offK = (unsigned)(kr * LDK8 + kc * 16), offR = (unsigned)(kr * LDKR8 + kc * 8);
#define MLA_SLOAD(i, k0) do { const unsigned char* vb_ = Vh + (size_t)(k0) * 128; const unsigned char* kb_ = K8 + (size_t)(k0) * LDK8; const unsigned char* rb_ = Kr8 + (size_t)(k0) * LDKR8; \
    sr_[i].vs = *(const u32x4*)(vb_ + offV); \
    sr_[i].kn = *(const u32x4*)(kb_ + offK); sr_[i].krp = *(const long*)(rb_ + offR); } while (0)
#define MLA_SWRITE(b, vo, i) do { *(u32x2*)(V_lds + (vo) + vst) = (u32x2){sr_[i].vs.x, sr_[i].vs.y}; *(u32x2*)(V_lds + (vo) + vst + 8) = (u32x2){sr_[i].vs.z, sr_[i].vs.w}; \
    *(u32x2*)(K_lds + (b) * SHM_K + kst) = (u32x2){sr_[i].kn.x, sr_[i].kn.y}; *(u32x2*)(K_lds + (b) * SHM_K + kst + 8) = (u32x2){sr_[i].kn.z, sr_[i].kn.w}; \
    *(long*)(K_lds + (b) * SHM_K + rst) = sr_[i].krp; } while (0)
#define MLA_SWAIT() do { if constexpr (SDEPTH == 2) asm volatile("s_waitcnt vmcnt(4)" ::: "memory"); else asm volatile("s_waitcnt vmcnt(0)" ::: "memory"); } while (0)
#define MLA_RESC(a) do { if (__any((a) < 1.f)) { if (hi == 0) al_l[r32] = (a); asm volatile("s_waitcnt lgkmcnt(0)" ::: "memory"); \
    _Pragma("unroll") for (int d = 0; d < 4; ++d) _Pragma("unroll") for (int r = 0; r < 16; ++r) o[d][r] *= al_l[crow(r, hi)]; } } while (0)
  f32x16 pA0, pA1, pB0, pB1; float alA, alB; long pa0, pa1, pa2, pa3; const int NT = seq / KVBLK;
  constexpr int SE = 0, SO = SDEPTH - 1;
  static_assert(SDEPTH == 1, "one tile of register staging");
#define MLA_VNEXT(v) ((v) + SHM_V == NVB * SHM_V ? 0 : (v) + SHM_V)
  MLA_SLOAD(SE, 0); asm volatile("s_waitcnt vmcnt(0)" ::: "memory"); MLA_SWRITE(0, 0, SE); __syncthreads();
  mla::VFrag fa, fb;
  qkt<0, false>(pA0, pA1, mneg, kb, qv, fa, fb, vb0); partialSM<true>(pA0, pA1, mneg, alA);
  MLA_SLOAD(SO, KVBLK);
  MLA_SWAIT(); MLA_SWRITE(1, SHM_V, SO); __syncthreads();
  int vo = 0;
  for (int j = 1; j + 1 < NT; j += 2) {
    { const int vw = MLA_VNEXT(MLA_VNEXT(vo));
      MLA_SBAR(); qkt<SHM_K, true>(pB0, pB1, mneg, kb, qv, fa, fb, vb0 + vo);
      finishSM(pA0, pA1, alA, l_reg, pa0, pa1, pa2, pa3); MLA_SBAR();
      MLA_SLOAD(SO, (j + 1) * KVBLK); MLA_SBAR();
      pv_d0_pre(o, vb0 + vo, pa0, pa1, pa2, pa3, fa, fb); partialSM<false>(pB0, pB1, mneg, alB); MLA_PIN2(pB0, pB1);
      MLA_SWAIT(); MLA_SWRITE(0, vw, SE);
      MLA_RESC(alB); __syncthreads(); vo = MLA_VNEXT(vo); }
    { const int vw = MLA_VNEXT(MLA_VNEXT(vo));
      MLA_SBAR(); qkt<0, true>(pA0, pA1, mneg, kb, qv, fa, fb, vb0 + vo);
      finishSM(pB0, pB1, alB, l_reg, pa0, pa1, pa2, pa3); MLA_SBAR();
      MLA_SLOAD(SE, (j + 2) * KVBLK); MLA_SBAR();
      pv_d0_pre(o, vb0 + vo, pa0, pa1, pa2, pa3, fa, fb); partialSM<false>(pA0, pA1, mneg, alA); MLA_PIN2(pA0, pA1);
      MLA_SWAIT(); MLA_SWRITE(1, vw, SO);
      MLA_RESC(alA); __syncthreads(); vo = MLA_VNEXT(vo); }
  }
  MLA_SBAR(); qkt<SHM_K, true>(pB0, pB1, mneg, kb, qv, fa, fb, vb0 + vo);
  finishSM(pA0, pA1, alA, l_reg, pa0, pa1, pa2, pa3); MLA_SBAR();
  pv_d0_pre(o, vb0 + vo, pa0, pa1, pa2, pa3, fa, fb); partialSM<false>(pB0, pB1, mneg, alB);
  MLA_RESC(alB);
  finishSM(pB0, pB1, alB, l_reg, pa0, pa1, pa2, pa3); MLA_SBAR();
  pv_d0(o, vb0 + MLA_VNEXT(vo), pa0, pa1, pa2, pa3);
#undef MLA_VNEXT
  if (hi == 0) li_l[r32] = l_reg; asm volatile("s_waitcnt lgkmcnt(0)" ::: "memory");
  { int tz = threadIdx.x; asm volatile("" : "+v"(tz));
    const int lane2 = tz & 63, r32b = lane2 & 31, hib = lane2 >> 5, widb = tz >> 6;
    unsigned char* Ow = Ob + (long)(widb * QBLK) * LDO + r32b;
#pragma unroll
    for (int r = 0; r < 16; ++r) { const int orow = crow(r, hib); const float rl = OSC * __builtin_amdgcn_rcpf(li_l[orow]);
#pragma unroll
      for (int d0 = 0; d0 < 4; ++d0) Ow[(long)orow * LDO + d0 * 32] = (unsigned char)(__builtin_amdgcn_cvt_pk_fp8_f32(o[d0][r] * rl, 0.f, 0, false) & 0xff); } }
#undef MLA_SLOAD
#undef MLA_SWRITE
#undef MLA_SWAIT
#undef MLA_RESC
}
}

constexpr int NWAVES = 8;
constexpr int BATCH = 4, SEQ = 4096, DM = 4096, M = BATCH * SEQ;
constexpr int CONV = 2048, QL = 1024, KVL = 512, NH = 16, DFF = 11008;
constexpr int IN_COLS = 15936, NZ = 16128;
constexpr int NQ = 3072, NKV = 4096, NGU = 2 * DFF;
constexpr float RMS_EPS = 1e-6f;

constexpr size_t MiB = 1u << 20;
constexpr size_t WS_CTL = 0, CTL_ZERO_BYTES = 1 * MiB;
constexpr size_t WS_WIN = 1 * MiB;
constexpr size_t WS_WQB = WS_WIN + (size_t)NZ * DM * 2;
constexpr size_t WS_WKVB = WS_WQB + (size_t)NQ * QL * 2;
constexpr size_t WS_WBR = WS_WKVB + (size_t)NKV * KVL * 2;
constexpr size_t WS_WOUT = WS_WBR + (size_t)DM * DM * 2;
constexpr size_t WS_WGU = WS_WOUT + (size_t)DM * DM * 2;
constexpr size_t WS_WDN = WS_WGU + (size_t)NGU * DM * 2;
constexpr size_t WS_RA = WS_WDN + (size_t)DM * DFF * 2;
constexpr size_t WS_ZC = WS_RA + (size_t)M * DM * 2;
constexpr size_t WS_ZS = WS_ZC + (size_t)M * 6144 * 2;
constexpr size_t WS_ZR = WS_ZS + (size_t)M * 1536 * 2;
constexpr size_t WS_ZG = WS_ZR + (size_t)M * 256 * 2;
constexpr size_t WS_H8 = WS_ZG + (size_t)M * 8192 * 2;
constexpr size_t WS_END = WS_H8 + (size_t)M * DM;
constexpr size_t WS_WG8 = WS_WIN;
constexpr size_t WS_KV = WS_ZC, WS_H2 = WS_ZC, WS_ACT = WS_ZC + (size_t)M * DM * 2;
static_assert(WS_ACT + (size_t)M * DFF * 2 <= WS_END, "act overlay fits");
constexpr size_t WS_SLOTS = WS_WIN + 64 * MiB, WS_INV = WS_SLOTS + (size_t)16384 * 64 * 4;
constexpr size_t WS_QN = WS_WIN, WS_KVN = WS_QN + (size_t)M * QL * 2, WS_KR = WS_KVN + (size_t)M * KVL * 2, WS_CS = WS_KR + (size_t)M * 64 * 2;
static_assert(WS_CS + (size_t)M * 64 * 4 <= WS_SLOTS && WS_INV + (size_t)16384 * 4 <= WS_WQB, "P2 / P6 small outputs fit in the dead Win_t region");
constexpr size_t DO_Y = 0, DO_QN = (size_t)M * DM * 2, DO_K8 = DO_QN + (size_t)M * 3072;
static_assert(DO_K8 + (size_t)M * 2048 <= (size_t)M * DM * 4, "d_out scratch fits");
constexpr int CW_TMO = 0, CW_BAR = 4096, CW_RANK = 8192;

constexpr int RING_OFF = 0, RING_BYTES = 131072;
constexpr int LDSCTL_OFF = RING_BYTES, MISC_OFF = LDSCTL_OFF + 320;
constexpr int LDS_BYTES = 147456;

#define GAS __attribute__((address_space(1)))
#define LAS __attribute__((address_space(3)))
typedef unsigned short bf16;
typedef unsigned v4u __attribute__((ext_vector_type(4)));
typedef unsigned v2u __attribute__((ext_vector_type(2)));
typedef float f32x4 __attribute__((ext_vector_type(4)));
typedef GAS unsigned gu32;
#define RLX_AGENT __ATOMIC_RELAXED, __HIP_MEMORY_SCOPE_AGENT
#define LDS_WAIT() asm volatile("s_waitcnt lgkmcnt(0)" ::: "memory")
__device__ __forceinline__ unsigned f2bf(float f) { unsigned u = __builtin_bit_cast(unsigned, f); return (u + 0x7fffu + ((u >> 16) & 1u)) >> 16; }
__device__ __forceinline__ unsigned pk2(float lo, float hi) { return f2bf(lo) | (f2bf(hi) << 16); }
__device__ __forceinline__ float bfl(unsigned w) { return __uint_as_float(w << 16); }
__device__ __forceinline__ float bfh(unsigned w) { return __uint_as_float(w & 0xffff0000u); }

#define XB_TMO      128
#define XB_XCNT(j)  (256  + 64 * (j))
#define XB_XSUB(j)  (1280 + 64 * (j))
#define XB_XGEN(j)  (2304 + 64 * (j))
#define XB_TOP      3328
#define XB_TOPGEN   3392
#define XCD_BAR_WORDS 3456
#define XB_SPIN_CAP (1u << 18)
__device__ __forceinline__ unsigned xb_ld(unsigned* p)              { return __hip_atomic_load(p, __ATOMIC_RELAXED, __HIP_MEMORY_SCOPE_AGENT); }
__device__ __forceinline__ unsigned xb_add(unsigned* p, unsigned v) { return __hip_atomic_fetch_add(p, v, __ATOMIC_RELAXED, __HIP_MEMORY_SCOPE_AGENT); }
__device__ __forceinline__ unsigned xb_xcc_id() { return (unsigned)__builtin_amdgcn_s_getreg((3 << 11) | 20) & 0xFu; }
#define XB_SPIN(cond, bar) do { unsigned _sp = 0; while (cond) { __builtin_amdgcn_s_sleep(1); \
    if ((++_sp & 255u) == 0u) { if (xb_ld(&(bar)[XB_TMO])) break; if (_sp > XB_SPIN_CAP) { atomicAdd(&(bar)[XB_TMO], 1u); break; } } } } while (0)
struct XcdBarrier { unsigned* bar; unsigned x; volatile LAS unsigned* st; };
__device__ __forceinline__ XcdBarrier xcd_barrier_post(unsigned* bar, volatile LAS unsigned* st) {
    XcdBarrier b; b.bar = bar; b.x = xb_xcc_id(); b.st = st;
    if (threadIdx.x == 0) (void)xb_add(&bar[XB_XCNT(b.x)], 1u);
    return b;
}
__device__ __forceinline__ void xcd_barrier_complete(unsigned* bar, unsigned x, unsigned& nloc, unsigned& nx) {
    const unsigned G = gridDim.x * gridDim.y * gridDim.z;
    unsigned sum, cnt, mine, sp = 0u;
    for (;;) {
        sum = 0u; cnt = 0u; mine = 0u;
#pragma unroll
        for (unsigned j = 0; j < 16; ++j) { const unsigned c = xb_ld(&bar[XB_XCNT(j)]); sum += c; cnt += (c > 0u) ? 1u : 0u; mine = (j == x) ? c : mine; }
        if (sum == G) break;
        __builtin_amdgcn_s_sleep(1);
        if ((++sp & 255u) == 0u) { if (xb_ld(&bar[XB_TMO])) break; if (sp > XB_SPIN_CAP) { atomicAdd(&bar[XB_TMO], 1u); break; } }
    }
    nloc = mine > 0u ? mine : 1u; nx = cnt > 0u ? cnt : 1u;
}
__device__ __forceinline__ void xcd_barrier(const XcdBarrier& b) {
    asm volatile("s_waitcnt vmcnt(0)" ::: "memory");
    __syncthreads();
    if (threadIdx.x == 0) {
        unsigned* bar = b.bar;
        __builtin_amdgcn_s_waitcnt(0);
        unsigned nloc = b.st[0], nx = b.st[1];
        if (nloc == 0u) { xcd_barrier_complete(bar, b.x, nloc, nx); b.st[0] = nloc; b.st[1] = nx; }
        const unsigned old = xb_add(&bar[XB_XSUB(b.x)], 1u);
        const unsigned gen = old / nloc;
        if (old + 1u == (gen + 1u) * nloc) {
            __builtin_amdgcn_fence(__ATOMIC_RELEASE, "agent");
            asm volatile("s_waitcnt vmcnt(0)" ::: "memory");
            const unsigned og = xb_add(&bar[XB_TOP], 1u);
            const unsigned tg = og / nx;
            if (og + 1u == (tg + 1u) * nx) xb_add(&bar[XB_TOPGEN], 1u);
            else XB_SPIN(xb_ld(&bar[XB_TOPGEN]) == tg, bar);
            __builtin_amdgcn_fence(__ATOMIC_ACQUIRE, "agent");
            xb_add(&bar[XB_XGEN(b.x)], 1u);
            asm volatile("s_waitcnt vmcnt(0)" ::: "memory");
        } else {
            XB_SPIN(xb_ld(&bar[XB_XGEN(b.x)]) == gen, bar);
            __builtin_amdgcn_fence(__ATOMIC_ACQUIRE, "agent");
            asm volatile("s_waitcnt vmcnt(0)" ::: "memory");
        }
    }
    __syncthreads();
}

__device__ __forceinline__ float wave_sum(float v) {
#pragma unroll
    for (int o = 1; o < 64; o <<= 1) v += __shfl_xor(v, o);
    return v;
}
enum { J_IN = 0, J_QB, J_KVB, J_BR, J_OUT, J_GU, J_DN };
template <int JOB> __device__ __forceinline__ int xmap(int n, int aux) {
    if constexpr (JOB == J_IN) return n;
    else if constexpr (JOB == J_QB) { const int h = n / 192, r = n % 192; return r < 128 ? h * 128 + r : 2048 + (h >> 2) * 256 + ((r - 128) >> 5) * 128 + (h & 3) * 32 + (r & 31); }
    else if constexpr (JOB == J_GU) return (n >> 7) * 256 + aux * 128 + (n & 127);
    else return n;
}
template <int JOB> __device__ __forceinline__ void xpose_tile(const float* W, int Nsrc, int tile, bf16* dst, int ldd, int kofs, int aux, const float* gk, int lane) {
    const int ntn = Nsrc >> 6, k0 = (tile / ntn) << 6, n0 = (tile % ntn) << 6, kb = lane >> 4, nq = lane & 15;
    const GAS f32x4* src = (const GAS f32x4*)(W + (size_t)(k0 + 16 * kb) * Nsrc + n0 + 4 * nq);
    f32x4 v[16];
#pragma unroll
    for (int i = 0; i < 16; ++i) v[i] = src[(size_t)i * (Nsrc >> 2)];
    if (gk) { const GAS f32x4* gp = (const GAS f32x4*)(gk + k0 + 16 * kb);
#pragma unroll
        for (int q = 0; q < 4; ++q) { const f32x4 g4 = gp[q]; v[4 * q] = v[4 * q] * g4.x; v[4 * q + 1] = v[4 * q + 1] * g4.y; v[4 * q + 2] = v[4 * q + 2] * g4.z; v[4 * q + 3] = v[4 * q + 3] * g4.w; } }
    const int nd = xmap<JOB>(n0 + 4 * nq, aux);
    bf16* drow = dst + (size_t)nd * ldd + kofs + k0 + 16 * kb;
#pragma unroll
    for (int j = 0; j < 4; ++j) { v4u a, b;
        a.x = pk2(v[0][j], v[1][j]); a.y = pk2(v[2][j], v[3][j]); a.z = pk2(v[4][j], v[5][j]); a.w = pk2(v[6][j], v[7][j]);
        b.x = pk2(v[8][j], v[9][j]); b.y = pk2(v[10][j], v[11][j]); b.z = pk2(v[12][j], v[13][j]); b.w = pk2(v[14][j], v[15][j]);
        GAS v4u* o = (GAS v4u*)(drow + (size_t)j * ldd); o[0] = a; o[1] = b; }
}
enum { J8_IN = 0, J8_QB, J8_KVB };
template <int JOB8> __device__ __forceinline__ int xmap8(int n) {
    if constexpr (JOB8 == J8_IN) return n >= 7744 ? n - 7744 : 8192 + (n - 6144);
    else if constexpr (JOB8 == J8_QB) return xmap<J_QB>(n, 0);
    else return n;
}
template <int JOB8> __device__ __forceinline__ void xpose_tile_fp8(const float* W, int Nsrc, int k0, int n0, unsigned char* dst, int ldd, float wsc, int lane) {
    const int kb = lane >> 4, nq = lane & 15;
    const GAS f32x4* src = (const GAS f32x4*)(W + (size_t)(k0 + 16 * kb) * Nsrc + n0 + 4 * nq);
    f32x4 v[16];
#pragma unroll
    for (int i = 0; i < 16; ++i) v[i] = src[(size_t)i * (Nsrc >> 2)] * wsc;
    unsigned char* drow = dst + (size_t)xmap8<JOB8>(n0 + 4 * nq) * ldd + k0 + 16 * kb;
#pragma unroll
    for (int j = 0; j < 4; ++j) { v4u a;
        a.x = pg8::pk4_fp8(v[0][j], v[1][j], v[2][j], v[3][j]); a.y = pg8::pk4_fp8(v[4][j], v[5][j], v[6][j], v[7][j]);
        a.z = pg8::pk4_fp8(v[8][j], v[9][j], v[10][j], v[11][j]); a.w = pg8::pk4_fp8(v[12][j], v[13][j], v[14][j], v[15][j]);
        *(GAS v4u*)(drow + (size_t)j * ldd) = a; }
}
template <bool OUTF> __device__ __forceinline__ void rms_row4096(const float* xrow, const float* g, void* orow, int lane) {
    const GAS f32x4* xr = (const GAS f32x4*)xrow + lane;
    f32x4 v[16]; float s = 0.f;
#pragma unroll
    for (int j = 0; j < 16; ++j) { v[j] = xr[64 * j]; s += (v[j].x * v[j].x + v[j].y * v[j].y) + (v[j].z * v[j].z + v[j].w * v[j].w); }
    const float inv = 1.0f / sqrtf(wave_sum(s) * (1.f / 4096.f) + RMS_EPS);
    const GAS f32x4* gr = (const GAS f32x4*)g + lane;
#pragma unroll
    for (int j = 0; j < 16; ++j) { const f32x4 gv = gr[64 * j]; const f32x4 o = v[j] * inv * gv;
        if constexpr (OUTF) ((GAS f32x4*)orow + lane)[64 * j] = o;
        else ((GAS unsigned long long*)orow + lane)[64 * j] = (unsigned long long)pk2(o.x, o.y) | ((unsigned long long)pk2(o.z, o.w) << 32); }
}

struct Args { const float* in[17]; float* out; unsigned char* ws; int ph_lo, ph_hi; };
static_assert(sizeof(Args) == 17 * 8 + 8 + 8 + 8, "no padding in Args");
constexpr int N_PHASES = 11;

__global__ void __launch_bounds__(NWAVES * 64, 2) mega_fwd(Args args) {
    extern __shared__ __attribute__((aligned(16))) unsigned char lds[];
    LAS unsigned char* L = (LAS unsigned char*)lds;
    volatile LAS unsigned* MISC = (volatile LAS unsigned*)(L + MISC_OFF);
    const int tid = threadIdx.x, lane = tid & 63, wave = __builtin_amdgcn_readfirstlane(tid >> 6);
    const int G = gridDim.x; const int bx = blockIdx.x; const int vcu = (G % 8 == 0) ? (bx % 8) * (G / 8) + bx / 8 : bx;
    unsigned char* ws = args.ws;
    gu32* ctl = (gu32*)(ws + WS_CTL);
    const float* x = args.in[0]; const int* positions = (const int*)args.in[1]; const float* g_mix = args.in[2]; const float* w_in = args.in[3];
    const float* b_gate = args.in[4]; const float* conv_w = args.in[5]; const float* g_q_a = args.in[6]; const float* w_q_b = args.in[7];
    const float* g_kv_a = args.in[8]; const float* w_kv_b = args.in[9]; const float* w_branch = args.in[10]; const float* w_out = args.in[11];
    const float* g_ffn = args.in[12]; const float* w_ffn_gate = args.in[13]; const float* w_ffn_up = args.in[14]; const float* w_ffn_down = args.in[15];
    const float* g_final = args.in[16];
    float* out = args.out; unsigned char* ob = (unsigned char*)args.out;
    unsigned char* Wg8_t = ws + WS_WG8; unsigned char* H8 = ws + WS_H8;
    bf16* Win_t = (bf16*)(ws + WS_WIN + 64 * MiB);
    bf16* Wbr_t = (bf16*)(ws + WS_WBR);
    bf16* Wout_t = (bf16*)(ws + WS_WOUT); bf16* Wgu_t = (bf16*)(ws + WS_WGU); bf16* Wdn_t = (bf16*)(ws + WS_WDN);
    bf16* RA = (bf16*)(ws + WS_RA); bf16* zc = (bf16*)(ws + WS_ZC); bf16* zs = (bf16*)(ws + WS_ZS); bf16* zr = (bf16*)(ws + WS_ZR); bf16* zg = (bf16*)(ws + WS_ZG);
    unsigned char* V8T = ws + WS_KV; bf16* H2 = (bf16*)(ws + WS_H2); bf16* ACT = (bf16*)(ws + WS_ACT);
    unsigned char* QN8 = ws + WS_QN; unsigned char* KVN8 = ws + WS_KVN; float* CS = (float*)(ws + WS_CS);
    unsigned char* Wqb8_t = ws + WS_WQB; unsigned char* Wkvb8_t = ws + WS_WKVB;
    float* SLOTS = (float*)(ws + WS_SLOTS); float* INV = (float*)(ws + WS_INV);
    bf16* Y = (bf16*)(ob + DO_Y); unsigned char* Q8 = ob + DO_QN; unsigned char* K8n = ob + DO_K8; unsigned char* KR8 = ws + WS_KR;

    for (int u = tid; u < (LDS_BYTES - LDSCTL_OFF) / 4; u += NWAVES * 64) ((LAS unsigned*)(L + LDSCTL_OFF))[u] = 0u;
    __syncthreads();
    XcdBarrier bar; bar.bar = (unsigned*)(ctl + CW_BAR); bar.x = 0; bar.st = nullptr;
    if (!MK_PER_PHASE) bar = xcd_barrier_post((unsigned*)(ctl + CW_BAR), MISC + 8);
    const int lo = args.ph_lo, hi = args.ph_hi;
#define IN(k) (lo <= (k) && (k) < hi)
#define SEAM(k) do { if (IN(k) && IN((k) + 1)) xcd_barrier(bar); } while (0)
    const int gw = vcu * NWAVES + wave, NGW = G * NWAVES;
    if (!MK_PER_PHASE && tid == 0) { const unsigned xcc_ = xb_xcc_id(); MISC[16] = xcc_; MISC[17] = __hip_atomic_fetch_add((unsigned*)(ctl + CW_RANK + 64 * xcc_), 1u, RLX_AGENT); }

    if (IN(0)) for (int rep_ = 0; rep_ < DUP(0); ++rep_) {
        constexpr int T_IN = (DM / 64) * (IN_COLS / 64), T_BR = (CONV / 64) * (DM / 64), T_G = (DM / 64) * (DFF / 64);
        constexpr int T_QB = (QL / 64) * (NQ / 64), T_KVB = (KVL / 64) * (NKV / 64), T_OUT = (DM / 64) * (DM / 64), T_DN = (DFF / 64) * (DM / 64);
        constexpr int NT0 = T_IN + 2 * T_G + T_QB + T_KVB;
        for (int it = gw; it < NT0; it += NGW) {
            int r = it;
            if (r < T_IN) { const int ntn_ = IN_COLS >> 6, n0_ = (r % ntn_) << 6;
                if (n0_ >= 6144) xpose_tile_fp8<J8_IN>(w_in, IN_COLS, (r / ntn_) << 6, n0_, Wg8_t, DM, 64.0f, lane);
                else xpose_tile<J_IN>(w_in, IN_COLS, r, Win_t, DM, 0, 0, nullptr, lane);
                continue; } r -= T_IN;
            if (r < 2 * T_G) { const int up = r / T_G; r -= up * T_G; xpose_tile<J_GU>(up ? w_ffn_up : w_ffn_gate, DFF, r, Wgu_t, DM, 0, up, g_ffn, lane); continue; } r -= 2 * T_G;
            if (r < T_QB) { const int ntn_ = NQ >> 6; xpose_tile_fp8<J8_QB>(w_q_b, NQ, (r / ntn_) << 6, (r % ntn_) << 6, Wqb8_t, QL, 32.0f, lane); continue; } r -= T_QB;
            { const int ntn_ = NKV >> 6; xpose_tile_fp8<J8_KVB>(w_kv_b, NKV, (r / ntn_) << 6, (r % ntn_) << 6, Wkvb8_t, KVL, 16.0f, lane); }
        }
        for (int rr = gw; rr < 192; rr += NGW) { GAS v4u* p = (GAS v4u*)(Wg8_t + (size_t)(9792 + rr) * DM) + lane;
#pragma unroll
            for (int j = 0; j < 4; ++j) p[64 * j] = (v4u){0u, 0u, 0u, 0u}; }
        for (int m = gw; m < M; m += NGW) {
            const GAS f32x4* xr = (const GAS f32x4*)(x + (size_t)m * DM) + lane; f32x4 v[16]; float s = 0.f;
#pragma unroll
            for (int j = 0; j < 16; ++j) { v[j] = xr[64 * j]; s += (v[j].x * v[j].x + v[j].y * v[j].y) + (v[j].z * v[j].z + v[j].w * v[j].w); }
            const float inv = 1.0f / sqrtf(wave_sum(s) * (1.f / 4096.f) + RMS_EPS);
            const GAS f32x4* gr = (const GAS f32x4*)g_mix + lane;
            GAS unsigned long long* ob_ = (GAS unsigned long long*)(RA + (size_t)m * DM) + lane; GAS unsigned* o8_ = (GAS unsigned*)(H8 + (size_t)m * DM) + lane;
#pragma unroll
            for (int j = 0; j < 16; ++j) { const f32x4 o = v[j] * inv * gr[64 * j];
                ob_[64 * j] = (unsigned long long)pk2(o.x, o.y) | ((unsigned long long)pk2(o.z, o.w) << 32); o8_[64 * j] = pg8::pk4_fp8(o.x, o.y, o.z, o.w); } }
    }
    SEAM(0);
    int cx = bx, vcx = vcu;
    if (!MK_PER_PHASE && lo == 0 && hi > 1) {
        bool uni = (G % 8 == 0);
        for (int j = 0; j < 16; ++j) { const unsigned cnt_ = __hip_atomic_load((unsigned*)(ctl + CW_BAR) + XB_XCNT(j), RLX_AGENT); uni = uni && (j < 8 ? cnt_ == (unsigned)(G / 8) : cnt_ == 0u); }
        if (uni) { const int xcc_ = (int)MISC[16], rk_ = (int)MISC[17]; cx = rk_ * 8 + xcc_; vcx = xcc_ * (G / 8) + rk_; }
    }
    cx = __builtin_amdgcn_readfirstlane(cx); vcx = __builtin_amdgcn_readfirstlane(vcx);

    if (IN(1)) for (int rep_ = 0; rep_ < DUP(1); ++rep_) {
        { pg8::Gemm g{(const bf16*)H8, (const bf16*)Wg8_t, M, 8192, DM / 2, DM / 2, DM / 2}; pg8::StaticOrder S; S.init(M, 8192, G, cx);
          pg8::EpiG8 E{(unsigned char*)zg, 1.0f / 64.0f};
          pg8::gemm_phase<pg8::EpiG8, pg8::StaticOrder, true, true, false, true, false, true>(L + RING_OFF, g, S, E); }
        { pg8::Gemm g{(const bf16*)H8, (const bf16*)(Wg8_t + (size_t)8192 * DM), M, 1792, DM / 2, DM / 2, DM / 2}; pg8::StaticOrder S; S.init(M, 1792, G, cx);
          pg8::EpiZ8 E{zg, zs, zr, 1.0f / 64.0f};
          pg8::gemm_phase<pg8::EpiZ8, pg8::StaticOrder, true, true, false, true, false, true>(L + RING_OFF, g, S, E); }
        { pg8::Gemm g{RA, Win_t, M, 6144, DM, DM, DM}; pg8::StaticOrder S; S.init(M, 6144, G, cx);
          pg8::EpiBf16 E{zc, 6144, 1.0f};
          pg8::gemm_phase<pg8::EpiBf16, pg8::StaticOrder, true, true>(L + RING_OFF, g, S, E); }
        { constexpr int T_BR = (CONV / 64) * (DM / 64), T_OUT = (DM / 64) * (DM / 64); const int rem = ((M / 256) * (1792 / 256)) % G, first = rem, nidle = G - first;
          int tz = threadIdx.x; asm volatile("" : "+v"(tz)); const int lane = tz & 63, wave = __builtin_amdgcn_readfirstlane(tz >> 6);
          if (cx >= first) for (int it = (cx - first) * NWAVES + wave; it < 2 * T_BR + T_OUT; it += nidle * NWAVES) { int r = it;
              if (r < T_BR) { xpose_tile<J_BR>(w_branch, DM, r, Wbr_t, DM, 0, 0, nullptr, lane); continue; } r -= T_BR;
              if (r < T_BR) { xpose_tile_fp8<J8_KVB>(w_branch + (size_t)CONV * DM, DM, (r / (DM >> 6)) << 6, (r % (DM >> 6)) << 6, (unsigned char*)Wbr_t + 4096, DM * 2, 32.0f, lane); continue; } r -= T_BR;
              xpose_tile<J_OUT>(w_out, DM, r, Wout_t, DM, 0, 0, nullptr, lane); } }
    }
    SEAM(1);

    if (IN(2)) for (int rep_ = 0; rep_ < DUP(2); ++rep_) {
        for (int m = gw; m < M; m += NGW) {
            const bf16* zrow = zs + (size_t)m * 1536;
            const v4u q0 = *(const GAS v4u*)(zrow + lane * 8), q1 = *(const GAS v4u*)(zrow + 512 + lane * 8), k0 = *(const GAS v4u*)(zrow + 1024 + lane * 8);
            const unsigned short rraw = zr[(size_t)m * 256 + lane];
            const int pos = positions[m];
            float qa[16], ka[8];
            qa[0] = bfl(q0.x); qa[1] = bfh(q0.x); qa[2] = bfl(q0.y); qa[3] = bfh(q0.y); qa[4] = bfl(q0.z); qa[5] = bfh(q0.z); qa[6] = bfl(q0.w); qa[7] = bfh(q0.w);
            qa[8] = bfl(q1.x); qa[9] = bfh(q1.x); qa[10] = bfl(q1.y); qa[11] = bfh(q1.y); qa[12] = bfl(q1.z); qa[13] = bfh(q1.z); qa[14] = bfl(q1.w); qa[15] = bfh(q1.w);
            ka[0] = bfl(k0.x); ka[1] = bfh(k0.x); ka[2] = bfl(k0.y); ka[3] = bfh(k0.y); ka[4] = bfl(k0.z); ka[5] = bfh(k0.z); ka[6] = bfl(k0.w); ka[7] = bfh(k0.w);
            float sq = 0.f, sk = 0.f;
#pragma unroll
            for (int j = 0; j < 16; ++j) sq += qa[j] * qa[j];
#pragma unroll
            for (int j = 0; j < 8; ++j) sk += ka[j] * ka[j];
            const float iq = 1.0f / sqrtf(wave_sum(sq) * (1.f / 1024.f) + RMS_EPS), ik = 1.0f / sqrtf(wave_sum(sk) * (1.f / 512.f) + RMS_EPS);
            const f32x4 ga0 = *(const GAS f32x4*)(g_q_a + lane * 8), ga1 = *(const GAS f32x4*)(g_q_a + lane * 8 + 4), gb0 = *(const GAS f32x4*)(g_q_a + 512 + lane * 8), gb1 = *(const GAS f32x4*)(g_q_a + 512 + lane * 8 + 4);
            const f32x4 gk0 = *(const GAS f32x4*)(g_kv_a + lane * 8), gk1 = *(const GAS f32x4*)(g_kv_a + lane * 8 + 4);
            v2u o;
            o.x = pg8::pk4_fp8(qa[0] * iq * ga0.x, qa[1] * iq * ga0.y, qa[2] * iq * ga0.z, qa[3] * iq * ga0.w); o.y = pg8::pk4_fp8(qa[4] * iq * ga1.x, qa[5] * iq * ga1.y, qa[6] * iq * ga1.z, qa[7] * iq * ga1.w);
            *(GAS v2u*)(QN8 + (size_t)m * QL + lane * 8) = o;
            o.x = pg8::pk4_fp8(qa[8] * iq * gb0.x, qa[9] * iq * gb0.y, qa[10] * iq * gb0.z, qa[11] * iq * gb0.w); o.y = pg8::pk4_fp8(qa[12] * iq * gb1.x, qa[13] * iq * gb1.y, qa[14] * iq * gb1.z, qa[15] * iq * gb1.w);
            *(GAS v2u*)(QN8 + (size_t)m * QL + 512 + lane * 8) = o;
            o.x = pg8::pk4_fp8(ka[0] * ik * gk0.x, ka[1] * ik * gk0.y, ka[2] * ik * gk0.z, ka[3] * ik * gk0.w); o.y = pg8::pk4_fp8(ka[4] * ik * gk1.x, ka[5] * ik * gk1.y, ka[6] * ik * gk1.z, ka[7] * ik * gk1.w);
            *(GAS v2u*)(KVN8 + (size_t)m * KVL + lane * 8) = o;
            const int i = lane & 31;
            const float invf = powf(10000.0f, -(float)(2 * i) * (1.0f / 64.0f));
            const float ang = (float)pos * invf; float sn, cn; sincosf(ang, &sn, &cn);
            const float mine = __uint_as_float(((unsigned)rraw) << 16), other = __shfl_xor(mine, 32);
            const float rot = lane < 32 ? (mine * cn - other * sn) : (other * sn + mine * cn);
            KR8[(size_t)m * 64 + lane] = (unsigned char)(__builtin_amdgcn_cvt_pk_fp8_f32(rot, 0.f, 0, false) & 0xff);
            if (lane < 32) { float2 c2; c2.x = cn; c2.y = sn; *(float2*)(CS + (size_t)m * 64 + 2 * i) = c2; }
        }
        for (int it = gw; it < (M / 32) * 4; it += NGW) {
            const int r0 = (it >> 2) * 32, c0 = (it & 3) * 512 + lane * 8;
            float w0[8], w1[8], w2[8];
#pragma unroll
            for (int j = 0; j < 8; ++j) { w0[j] = conv_w[c0 + j]; w1[j] = conv_w[CONV + c0 + j]; w2[j] = conv_w[2 * CONV + c0 + j]; }
            float up[8], uc[8], un[8];
#define CONV_U(dst, row) do { const v4u cc = *(const GAS v4u*)(zc + (size_t)(row) * 6144 + 2048 + c0), ch = *(const GAS v4u*)(zc + (size_t)(row) * 6144 + 4096 + c0); \
            dst[0] = bfl(cc.x) * bfl(ch.x); dst[1] = bfh(cc.x) * bfh(ch.x); dst[2] = bfl(cc.y) * bfl(ch.y); dst[3] = bfh(cc.y) * bfh(ch.y); \
            dst[4] = bfl(cc.z) * bfl(ch.z); dst[5] = bfh(cc.z) * bfh(ch.z); dst[6] = bfl(cc.w) * bfl(ch.w); dst[7] = bfh(cc.w) * bfh(ch.w); } while (0)
            if ((r0 & (SEQ - 1)) != 0) CONV_U(up, r0 - 1); else {
#pragma unroll
                for (int j = 0; j < 8; ++j) up[j] = 0.f; }
            CONV_U(uc, r0);
            const bool tail_ok = ((r0 + 32) & (SEQ - 1)) != 0;
#pragma unroll 4
            for (int r = r0; r < r0 + 32; ++r) {
                if (r + 1 < r0 + 32 || tail_ok) CONV_U(un, r + 1); else {
#pragma unroll
                    for (int j = 0; j < 8; ++j) un[j] = 0.f; }
                const v4u cb = *(const GAS v4u*)(zc + (size_t)r * 6144 + c0);
                float yv[8];
#pragma unroll
                for (int j = 0; j < 8; ++j) yv[j] = w0[j] * up[j] + w1[j] * uc[j] + w2[j] * un[j];
                v4u o; o.x = pk2(bfl(cb.x) * yv[0], bfh(cb.x) * yv[1]); o.y = pk2(bfl(cb.y) * yv[2], bfh(cb.y) * yv[3]); o.z = pk2(bfl(cb.z) * yv[4], bfh(cb.z) * yv[5]); o.w = pk2(bfl(cb.w) * yv[6], bfh(cb.w) * yv[7]);
                *(GAS v4u*)(Y + (size_t)r * DM + c0) = o;
#pragma unroll
                for (int j = 0; j < 8; ++j) { up[j] = uc[j]; uc[j] = un[j]; }
            }
#undef CONV_U
        }
    }
    SEAM(2);

    if (IN(3)) for (int rep_ = 0; rep_ < DUP(3); ++rep_) {
        { pg8::Gemm g{(const bf16*)QN8, (const bf16*)Wqb8_t, M, NQ, QL / 2, QL / 2, QL / 2}; pg8::StaticOrder S; S.init(M, NQ, G, cx);
          pg8::EpiQ E{Q8, CS, mla::SCALE * 1.4426950408889634f / 32.0f};
          pg8::gemm_phase<pg8::EpiQ, pg8::StaticOrder, true, true, false, true>(L + RING_OFF, g, S, E); }
        { pg8::Gemm g{(const bf16*)KVN8, (const bf16*)Wkvb8_t, M, NKV, KVL / 2, KVL / 2, KVL / 2}; pg8::StaticOrder S; S.init(M, NKV, G, cx);
          pg8::EpiKV E{K8n, V8T, 1.0f / 16.0f};
          pg8::gemm_phase<pg8::EpiKV, pg8::StaticOrder, true, true, false, true>(L + RING_OFF, g, S, E); }
    }
    SEAM(3);

    if (IN(4)) for (int rep_ = 0; rep_ < DUP(4); ++rep_) {
        for (int i = 0; ; ++i) {
            const int u = i * G + vcx; if (u >= BATCH * NH * (SEQ / 256)) break;
            const int bh = u >> 4, qb = u & 15, b = bh >> 4, h = bh & 15;
            const size_t q0 = (size_t)b * SEQ + (size_t)qb * 256, kbase = (size_t)b * SEQ;
            mla::attn_unit(Q8 + q0 * 3072 + h * 192, K8n + kbase * 2048 + h * 128, KR8 + kbase * 64, V8T + (size_t)bh * (64 * 8192),
                           (unsigned char*)Y + q0 * (DM * 2) + 4096 + h * 128, SEQ, (char*)lds + RING_OFF);
            __syncthreads();
        }
    }
    SEAM(4);

    if (IN(5)) for (int rep_ = 0; rep_ < DUP(5); ++rep_) {
        pg8::Gemm g{Y, Wbr_t, M, DM, 3072, DM, DM}; pg8::StaticOrder S; S.init(M, DM, G, cx);
        pg8::EpiGate E{(const unsigned char*)zg, b_gate, RA};
        pg8::gemm_phase<pg8::EpiGate, pg8::StaticOrder, true, true, false, false, true>(L + RING_OFF, g, S, E);
    }
    SEAM(5);

    if (IN(6)) for (int rep_ = 0; rep_ < DUP(6); ++rep_) {
        pg8::Gemm g{RA, Wout_t, M, DM, DM, DM, DM}; pg8::StaticOrder S; S.init(M, DM, G, cx);
        pg8::EpiRes1 E{x, H2, SLOTS, DM};
        pg8::gemm_phase<pg8::EpiRes1, pg8::StaticOrder, true, true>(L + RING_OFF, g, S, E);
    }
    SEAM(6);

    if (IN(7)) for (int rep_ = 0; rep_ < DUP(7); ++rep_) {
        int tz_ = threadIdx.x; asm volatile("" : "+v"(tz_)); const int lane = tz_ & 63;
        for (int m = gw; m < M; m += NGW) { const float s = wave_sum(SLOTS[(size_t)m * 64 + lane]); if (lane == 0) INV[m] = 1.0f / sqrtf(s * (1.f / 4096.f) + RMS_EPS); }
    }
    SEAM(7);

    if (IN(8)) for (int rep_ = 0; rep_ < DUP(8); ++rep_) {
        pg8::Gemm g{H2, Wgu_t, M, NGU, DM, DM, DM}; pg8::StaticOrder S; S.init(M, NGU, G, cx);
        pg8::EpiSwiGLU E{ACT, DFF, INV};
        pg8::gemm_phase<pg8::EpiSwiGLU, pg8::StaticOrder, true, true>(L + RING_OFF, g, S, E);
        { constexpr int T_DN = (DFF / 64) * (DM / 64); const int rem = S.nwg % G, first = rem, nidle = G - first;
          int tz_ = threadIdx.x; asm volatile("" : "+v"(tz_)); const int lane = tz_ & 63;
          if (cx >= first) for (int it = (cx - first) * NWAVES + wave; it < T_DN; it += nidle * NWAVES) xpose_tile<J_DN>(w_ffn_down, DM, it, Wdn_t, DFF, 0, 0, nullptr, lane); }
    }
    SEAM(8);

    if (IN(9)) for (int rep_ = 0; rep_ < DUP(9); ++rep_) {
        pg8::Gemm g{ACT, Wdn_t, M, DM, DFF, DFF, DFF}; pg8::StaticOrder S; S.init(M, DM, G, cx, 4);
        pg8::EpiResB E{H2, DM};
        pg8::gemm_phase<pg8::EpiResB, pg8::StaticOrder, true, true>(L + RING_OFF, g, S, E);
    }
    SEAM(9);

    if (IN(10)) for (int rep_ = 0; rep_ < DUP(10); ++rep_) {
        int tz_ = threadIdx.x; asm volatile("" : "+v"(tz_)); const int lane = tz_ & 63;
        for (int m = gw; m < M; m += NGW) {
            const GAS v4u* xr = (const GAS v4u*)(H2 + (size_t)m * DM) + lane; v4u v[8]; float s = 0.f;
#pragma unroll
            for (int j = 0; j < 8; ++j) { v[j] = xr[64 * j];
                s += (bfl(v[j].x) * bfl(v[j].x) + bfh(v[j].x) * bfh(v[j].x)) + (bfl(v[j].y) * bfl(v[j].y) + bfh(v[j].y) * bfh(v[j].y))
                   + (bfl(v[j].z) * bfl(v[j].z) + bfh(v[j].z) * bfh(v[j].z)) + (bfl(v[j].w) * bfl(v[j].w) + bfh(v[j].w) * bfh(v[j].w)); }
            const float inv = 1.0f / sqrtf(wave_sum(s) * (1.f / 4096.f) + RMS_EPS);
            const GAS f32x4* gr = (const GAS f32x4*)g_final + 2 * lane; GAS f32x4* orow = (GAS f32x4*)(out + (size_t)m * DM) + 2 * lane;
#pragma unroll
            for (int j = 0; j < 8; ++j) { const f32x4 g0 = gr[128 * j], g1 = gr[128 * j + 1];
                orow[128 * j] = (f32x4){bfl(v[j].x) * inv * g0.x, bfh(v[j].x) * inv * g0.y, bfl(v[j].y) * inv * g0.z, bfh(v[j].y) * inv * g0.w};
                orow[128 * j + 1] = (f32x4){bfl(v[j].z) * inv * g1.x, bfh(v[j].z) * inv * g1.y, bfl(v[j].w) * inv * g1.z, bfh(v[j].w) * inv * g1.w}; }
        }
    }
#undef IN
#undef SEAM
}

extern "C" void kernel_launch(void* const* d_in, const int* in_sizes, int n_in, void* d_out, int out_size, void* d_ws, size_t ws_size, hipStream_t stream) {
    static int grid = 0;
    if (grid == 0) {
        if (n_in != 17 || in_sizes[0] != M * DM || out_size != M * DM || ws_size < WS_END) { fprintf(stderr, "kernel_launch: shape/workspace mismatch (n_in %d, in0 %d, out %d, ws %zu, need %zu)\n", n_in, n_in > 0 ? in_sizes[0] : -1, out_size, ws_size, (size_t)WS_END); grid = -1; return; }
        int dev = 0, cus = 0, per_cu = 0;
        if (hipGetDevice(&dev) != hipSuccess || hipDeviceGetAttribute(&cus, hipDeviceAttributeMultiprocessorCount, dev) != hipSuccess) { grid = -1; return; }
        if (hipFuncSetAttribute((const void*)mega_fwd, hipFuncAttributeMaxDynamicSharedMemorySize, LDS_BYTES) != hipSuccess) { fprintf(stderr, "kernel_launch: hipFuncSetAttribute failed\n"); grid = -1; return; }
        if (hipOccupancyMaxActiveBlocksPerMultiprocessor(&per_cu, (const void*)mega_fwd, NWAVES * 64, LDS_BYTES) != hipSuccess || per_cu < 1)
            fprintf(stderr, "kernel_launch: note: occupancy query reports %d workgroups per CU\n", per_cu);
        (void)hipGetLastError();
        grid = cus;
    }
    if (grid < 0) return;
    if (hipMemsetAsync((char*)d_ws + WS_CTL, 0, CTL_ZERO_BYTES, stream) != hipSuccess) return;
    Args a{};
    for (int i = 0; i < 17; ++i) a.in[i] = (const float*)d_in[i];
    a.out = (float*)d_out; a.ws = (unsigned char*)d_ws;
#if MK_PER_PHASE
    for (int p = 0; p < N_PHASES; ++p) { a.ph_lo = p; a.ph_hi = p + 1; hipLaunchKernelGGL(mega_fwd, dim3(grid), dim3(NWAVES * 64), LDS_BYTES, stream, a); }
#else
    a.ph_lo = 0; a.ph_hi = N_PHASES;
    hipLaunchKernelGGL(mega_fwd, dim3(grid), dim3(NWAVES * 64), LDS_BYTES, stream, a);
#endif
    const hipError_t le = hipPeekAtLastError();
    if (le != hipSuccess) fprintf(stderr, "kernel_launch: launch failed: %s\n", hipGetErrorName(le));
}
```

```cpp
#include <hip/hip_runtime.h>
#include <hip/hip_bf16.h>
#include <cstdio>
#include <cstdint>

#ifndef PROBE_DUP
#define PROBE_DUP -1
#endif
#define DUP(k) (PROBE_DUP == (k) ? 2 : 1)
#ifndef MK_PER_PHASE
#define MK_PER_PHASE 0
#endif

namespace pg8 {
#define PG8_LAS __attribute__((address_space(3)))
typedef unsigned short bf16_t;
typedef short bf16x8 __attribute__((ext_vector_type(8)));
typedef float f32x4 __attribute__((ext_vector_type(4)));
typedef float f32x2 __attribute__((ext_vector_type(2)));
typedef unsigned u32x4 __attribute__((ext_vector_type(4)));
constexpr int BM = 256, BK = 64, HALF = 128, HTB = HALF * BK * 2, STAGE_BYTES = 8 * HTB, NXCD = 8, WGM = 8;

__host__ __device__ __forceinline__ int lds_byte(int r, int c) { const int st = (r >> 4) * 2 + (c >> 5), rr = r & 15, cc = c & 31, ob = rr * 64 + cc * 2; return st * 1024 + (ob ^ (((ob >> 9) & 1) << 5)); }
__host__ __device__ __forceinline__ void stage_rc(int b, int& R, int& C) { const int st = b / 1024, sb = b % 1024, swz = sb ^ (((sb >> 9) & 1) << 5); R = (st >> 1) * 16 + swz / 64; C = (st & 1) * 32 + (swz % 64) / 2; }
__host__ __device__ __forceinline__ int perm32(int rho) { const int n = rho >> 4, i = rho & 15; return 8 * (i >> 2) + 4 * n + (i & 3); }

__device__ __forceinline__ int lane_id() { int r; asm volatile("v_mbcnt_lo_u32_b32 %0, -1, 0\n\tv_mbcnt_hi_u32_b32 %0, -1, %0" : "=v"(r)); return r; }
struct Unit { int pm, pn; };
struct Gemm { const bf16_t* A; const bf16_t* Bt; int M, N, K, lda, ldb; };

struct StaticOrder {
    int nM, nN, nwg, G, c, wgm;
    __host__ __device__ void init(int M, int N, int G_, int c_, int wgm_ = WGM) { nM = M / BM; nN = N / BM; nwg = nM * nN; G = G_; c = c_; wgm = wgm_; }
    __host__ __device__ bool next(int i, Unit& u) const {
        const long L = (long)i * G + c; if (L >= nwg) return false;
        int wgid = (int)L; { const int q = nwg / NXCD, r = nwg % NXCD, xcd = wgid % NXCD, off = wgid / NXCD; wgid = (xcd < r ? xcd * (q + 1) : r * (q + 1) + (xcd - r) * q) + off; }
        const int nig = wgm * nN, gid = wgid / nig, fm = gid * wgm, gsz = (nM - fm) < wgm ? (nM - fm) : wgm;
        u.pm = fm + ((wgid % nig) % gsz); u.pn = (wgid % nig) / gsz; return true;
    }
    __device__ __forceinline__ void a_ready(const Unit&) const {}
    __device__ __forceinline__ void done(const Unit&) const {}
};

__device__ __forceinline__ unsigned cvt_pk_bf16(float lo, float hi) { unsigned r; asm volatile("v_cvt_pk_bf16_f32 %0, %1, %2" : "=v"(r) : "v"(lo), "v"(hi)); return r; }
__device__ __forceinline__ unsigned pk4_fp8(float a, float b, float c, float d) { int w = __builtin_amdgcn_cvt_pk_fp8_f32(a, b, 0, false); w = __builtin_amdgcn_cvt_pk_fp8_f32(c, d, w, true); return (unsigned)w; }
typedef unsigned u32x2 __attribute__((ext_vector_type(2)));
__device__ __forceinline__ float bf_lo(unsigned w) { return __uint_as_float(w << 16); }
__device__ __forceinline__ float bf_hi(unsigned w) { return __uint_as_float(w & 0xffff0000u); }
__device__ __forceinline__ float sigmoidf_fast(float v) { return __builtin_amdgcn_rcpf(1.0f + __expf(-v)); }

typedef f32x4 Acc[2][2][4][2];

__device__ __forceinline__ void store_tile_bf16(const Acc& acc, bf16_t* base, int ldc, int row0, int col0, float sc = 1.0f) {
#pragma unroll
    for (int ai = 0; ai < 2; ++ai)
#pragma unroll
        for (int m = 0; m < 4; ++m) { bf16_t* rowp = base + (size_t)(row0 + ai * HALF + m * 16) * ldc + col0;
#pragma unroll
            for (int bj = 0; bj < 2; ++bj) { const f32x4 v0 = acc[ai][bj][m][0] * sc, v1 = acc[ai][bj][m][1] * sc;
                u32x4 w; w.x = cvt_pk_bf16(v0[0], v0[1]); w.y = cvt_pk_bf16(v0[2], v0[3]); w.z = cvt_pk_bf16(v1[0], v1[1]); w.w = cvt_pk_bf16(v1[2], v1[3]);
                *(u32x4*)(rowp + bj * HALF) = w; } }
}

struct EpiZ {
    static constexpr bool PERM = true, HAS_MID = false; static constexpr int NST = 16;
    bf16_t *zc, *zs, *zg, *zr;
    __device__ __forceinline__ void operator()(const Acc& acc, const Unit& u, int wr, int wc, int fr, int fq) const {
        const int pn = u.pn; bf16_t* base; int ldc, colt;
        if (pn < 24) { base = zc; ldc = 6144; colt = pn * 256; }
        else if (pn < 30) { base = zs; ldc = 1536; colt = (pn - 24) * 256; }
        else { base = zr; ldc = 256; colt = 0; }
        store_tile_bf16(acc, base, ldc, u.pm * BM + wr * 64 + fr, colt + wc * 32 + 8 * fq);
    }
};
struct EpiG8 {
    static constexpr bool PERM = true, HAS_MID = false; static constexpr int NST = 16;
    unsigned char* zg; float sc;
    __device__ __forceinline__ void operator()(const Acc& acc, const Unit& u, int wr, int wc, int, int) const {
        int lane_ = lane_id(); asm volatile("" : "+v"(lane_));
        const int fr = lane_ & 15, fq = lane_ >> 4;
        unsigned char* zb = zg + (size_t)(u.pm * BM + wr * 64 + fr) * 8192 + u.pn * 256 + wc * 32 + 8 * fq;
#pragma unroll
        for (int ai = 0; ai < 2; ++ai)
#pragma unroll
            for (int m = 0; m < 4; ++m)
#pragma unroll
                for (int bj = 0; bj < 2; ++bj) { const f32x4 v0 = acc[ai][bj][m][0] * sc, v1 = acc[ai][bj][m][1] * sc;
                    u32x2 w; w.x = pk4_fp8(v0[0], v0[1], v0[2], v0[3]); w.y = pk4_fp8(v1[0], v1[1], v1[2], v1[3]);
                    *(u32x2*)(zb + (size_t)(ai * HALF + m * 16) * 8192 + bj * HALF) = w; }
    }
};
struct EpiZ8 {
    static constexpr bool PERM = true, HAS_MID = false; static constexpr int NST = 16;
    bf16_t *zg, *zs, *zr; float sc;
    __device__ __forceinline__ void operator()(const Acc& acc, const Unit& u, int wr, int wc, int, int) const {
        int lane_ = lane_id(); asm volatile("" : "+v"(lane_));
        const int fr = lane_ & 15, fq = lane_ >> 4;
        const int pn = u.pn; bf16_t* base; int ldc, colt;
        if (pn < 6) { base = zs; ldc = 1536; colt = pn * 256; }
        else { base = zr; ldc = 256; colt = 0; }
        store_tile_bf16(acc, base, ldc, u.pm * BM + wr * 64 + fr, colt + wc * 32 + 8 * fq, sc);
    }
};
struct EpiBf16 {
    static constexpr bool PERM = true, HAS_MID = false; static constexpr int NST = 16;
    bf16_t* O; int ldc; float sc;
    __device__ __forceinline__ void operator()(const Acc& acc, const Unit& u, int wr, int wc, int fr, int fq) const {
        store_tile_bf16(acc, O, ldc, u.pm * BM + wr * 64 + fr, u.pn * BM + wc * 32 + 8 * fq, sc);
    }
};
struct EpiQ {
    static constexpr bool PERM = true, HAS_MID = false; static constexpr int NST = 16;
    unsigned char* Q8; const float* cs; float sc;
    __device__ __forceinline__ void operator()(const Acc& acc, const Unit& u, int wr, int wc, int fr, int fq) const {
        const int row0 = u.pm * BM + wr * 64 + fr;
        if (u.pn < 8) {
#pragma unroll
            for (int ai = 0; ai < 2; ++ai)
#pragma unroll
                for (int m = 0; m < 4; ++m) { unsigned char* rowp = Q8 + (size_t)(row0 + ai * HALF + m * 16) * 3072 + wc * 32 + 8 * fq;
#pragma unroll
                    for (int bj = 0; bj < 2; ++bj) { const f32x4 v0 = acc[ai][bj][m][0] * sc, v1 = acc[ai][bj][m][1] * sc;
                        u32x2 w; w.x = pk4_fp8(v0[0], v0[1], v0[2], v0[3]); w.y = pk4_fp8(v1[0], v1[1], v1[2], v1[3]);
                        *(u32x2*)(rowp + (2 * u.pn + bj) * 192) = w; } }
            return; }
        const int head = 4 * (u.pn - 8) + wc, i0 = 8 * fq;
#pragma unroll
        for (int ai = 0; ai < 2; ++ai)
#pragma unroll
            for (int m = 0; m < 4; ++m) { const int row = row0 + ai * HALF + m * 16;
                const f32x4* cp = (const f32x4*)(cs + (size_t)row * 64 + i0 * 2);
                const f32x4 c01 = cp[0], c23 = cp[1], c45 = cp[2], c67 = cp[3];
                const f32x4 a0 = acc[ai][0][m][0] * sc, a1 = acc[ai][0][m][1] * sc, b0 = acc[ai][1][m][0] * sc, b1 = acc[ai][1][m][1] * sc;
                float o1[8], o2[8];
                o1[0] = a0[0] * c01[0] - b0[0] * c01[1]; o2[0] = a0[0] * c01[1] + b0[0] * c01[0];
                o1[1] = a0[1] * c01[2] - b0[1] * c01[3]; o2[1] = a0[1] * c01[3] + b0[1] * c01[2];
                o1[2] = a0[2] * c23[0] - b0[2] * c23[1]; o2[2] = a0[2] * c23[1] + b0[2] * c23[0];
                o1[3] = a0[3] * c23[2] - b0[3] * c23[3]; o2[3] = a0[3] * c23[3] + b0[3] * c23[2];
                o1[4] = a1[0] * c45[0] - b1[0] * c45[1]; o2[4] = a1[0] * c45[1] + b1[0] * c45[0];
                o1[5] = a1[1] * c45[2] - b1[1] * c45[3]; o2[5] = a1[1] * c45[3] + b1[1] * c45[2];
                o1[6] = a1[2] * c67[0] - b1[2] * c67[1]; o2[6] = a1[2] * c67[1] + b1[2] * c67[0];
                o1[7] = a1[3] * c67[2] - b1[3] * c67[3]; o2[7] = a1[3] * c67[3] + b1[3] * c67[2];
                u32x2 w1, w2;
                w1.x = pk4_fp8(o1[0], o1[1], o1[2], o1[3]); w1.y = pk4_fp8(o1[4], o1[5], o1[6], o1[7]);
                w2.x = pk4_fp8(o2[0], o2[1], o2[2], o2[3]); w2.y = pk4_fp8(o2[4], o2[5], o2[6], o2[7]);
                unsigned char* rowp = Q8 + (size_t)row * 3072 + head * 192 + 128 + i0;
                *(u32x2*)rowp = w1; *(u32x2*)(rowp + 32) = w2; }
    }
};
struct EpiKV {
    static constexpr bool PERM = true, HAS_MID = false; static constexpr int NST = 16;
    unsigned char* K8n; unsigned char* V8T; float sc;
    __device__ __forceinline__ void operator()(const Acc& acc, const Unit& u, int wr, int wc, int fr, int fq) const {
        const int row0 = u.pm * BM + wr * 64 + fr, c0 = wc * 32 + 8 * fq;
        const int q = fr & 3; const unsigned sel = (unsigned)q | ((unsigned)(4 + q) << 8) | 0x0c0c0000u;
        unsigned char* vt = V8T + ((size_t)(((u.pm >> 4) * 16 + u.pn) * 64 + (u.pm & 15) * 4 + wr) * 128 + c0 + q) * 64 + 4 * (fr >> 2);
#pragma unroll
        for (int ai = 0; ai < 2; ++ai)
#pragma unroll
            for (int m = 0; m < 4; ++m) { const size_t row = (size_t)(row0 + ai * HALF + m * 16);
                { const f32x4 v0 = acc[ai][0][m][0] * sc, v1 = acc[ai][0][m][1] * sc; u32x2 w; w.x = pk4_fp8(v0[0], v0[1], v0[2], v0[3]); w.y = pk4_fp8(v1[0], v1[1], v1[2], v1[3]);
                  *(u32x2*)(K8n + row * 2048 + u.pn * 128 + c0) = w; }
#pragma unroll
                for (int n = 0; n < 2; ++n) { const f32x4 v = acc[ai][1][m][n] * sc; const int W = (int)pk4_fp8(v[0], v[1], v[2], v[3]);
                    const unsigned x0 = (unsigned)__builtin_amdgcn_update_dpp(0, W, 0x00, 0xF, 0xF, true), x1 = (unsigned)__builtin_amdgcn_update_dpp(0, W, 0x55, 0xF, 0xF, true);
                    const unsigned x2 = (unsigned)__builtin_amdgcn_update_dpp(0, W, 0xAA, 0xF, 0xF, true), x3 = (unsigned)__builtin_amdgcn_update_dpp(0, W, 0xFF, 0xF, 0xF, true);
                    const unsigned t01 = __builtin_amdgcn_perm(x1, x0, sel), t23 = __builtin_amdgcn_perm(x3, x2, sel);
                    *(unsigned*)(vt + (size_t)(ai * 2) * (128 * 64) + (4 * n) * 64 + 16 * m) = __builtin_amdgcn_perm(t23, t01, 0x05040100u); } }
    }
};
struct EpiGate {
    static constexpr bool PERM = true, HAS_MID = true; static constexpr int NST = 8;
    static constexpr int KSW = 32;
    static constexpr float SB = 2048.0f;
    const unsigned char* zg; const float* bg; bf16_t* O;
#define F8(w, i) __builtin_amdgcn_cvt_f32_fp8((int)(w), i)
    __device__ __forceinline__ static float pre(float z, float b) { return fminf(fmaxf(z + b, -40.f), 40.f); }
    __device__ __forceinline__ static float ratio(float za, float ba, float zb, float bb) { return SB * (1.0f + __expf(-pre(zb, bb))) * __builtin_amdgcn_rcpf(1.0f + __expf(-pre(za, ba))); }
    __device__ __forceinline__ static float sg(float z, float b) { return (1.0f / SB) * __builtin_amdgcn_rcpf(1.0f + __expf(-pre(z, b))); }
    __device__ __forceinline__ void mid(Acc& acc, const Unit& u, int wr_, int wc_, int, int) const {
        int tz = (wr_ * 4 + wc_) * 64 + lane_id(); asm volatile("" : "+v"(tz));
        const int wid_ = tz >> 6, lane_ = tz & 63, wr = wid_ >> 2, wc = wid_ & 3, fr = lane_ & 15, fq = lane_ >> 4;
        const int row0 = u.pm * BM + wr * 64 + fr, col0 = u.pn * BM + wc * 32 + 8 * fq;
#pragma unroll
        for (int bj = 0; bj < 2; ++bj) { const int col = col0 + bj * HALF;
            const f32x4 bA0 = *(const f32x4*)(bg + col), bA1 = *(const f32x4*)(bg + col + 4), bB0 = *(const f32x4*)(bg + 4096 + col), bB1 = *(const f32x4*)(bg + 4096 + col + 4);
#pragma unroll
            for (int ai = 0; ai < 2; ++ai) { u32x2 ga[4], gb[4];
#pragma unroll
                for (int m = 0; m < 4; ++m) { const unsigned char* rp = zg + (size_t)(row0 + ai * HALF + m * 16) * 8192 + col; ga[m] = *(const u32x2*)rp; gb[m] = *(const u32x2*)(rp + 4096); }
                asm volatile("s_waitcnt vmcnt(0)" ::: "memory");
#pragma unroll
                for (int m = 0; m < 4; ++m) { const u32x2 a = ga[m], b = gb[m]; f32x4 r0, r1;
                    r0[0] = ratio(F8(a.x, 0), bA0[0], F8(b.x, 0), bB0[0]); r0[1] = ratio(F8(a.x, 1), bA0[1], F8(b.x, 1), bB0[1]);
                    r0[2] = ratio(F8(a.x, 2), bA0[2], F8(b.x, 2), bB0[2]); r0[3] = ratio(F8(a.x, 3), bA0[3], F8(b.x, 3), bB0[3]);
                    r1[0] = ratio(F8(a.y, 0), bA1[0], F8(b.y, 0), bB1[0]); r1[1] = ratio(F8(a.y, 1), bA1[1], F8(b.y, 1), bB1[1]);
                    r1[2] = ratio(F8(a.y, 2), bA1[2], F8(b.y, 2), bB1[2]); r1[3] = ratio(F8(a.y, 3), bA1[3], F8(b.y, 3), bB1[3]);
                    acc[ai][bj][m][0] *= r0; acc[ai][bj][m][1] *= r1; }
                asm volatile("" ::: "memory"); }
            asm volatile("" ::: "memory"); }
    }
    __device__ __forceinline__ void operator()(const Acc& acc, const Unit& u, int wr, int wc, int fr, int fq) const {
        const int row0 = u.pm * BM + wr * 64 + fr, col0 = u.pn * BM + wc * 32 + 8 * fq;
#pragma unroll
        for (int bj = 0; bj < 2; ++bj) { const int col = col0 + bj * HALF;
            u32x2 gb[2][4];
#pragma unroll
            for (int ai = 0; ai < 2; ++ai)
#pragma unroll
                for (int m = 0; m < 4; ++m) gb[ai][m] = *(const u32x2*)(zg + (size_t)(row0 + ai * HALF + m * 16) * 8192 + 4096 + col);
            const f32x4 bB0 = *(const f32x4*)(bg + 4096 + col), bB1 = *(const f32x4*)(bg + 4096 + col + 4);
            asm volatile("s_waitcnt vmcnt(0)" ::: "memory");
#pragma unroll
            for (int ai = 0; ai < 2; ++ai)
#pragma unroll
                for (int m = 0; m < 4; ++m) { const size_t row = (size_t)(row0 + ai * HALF + m * 16); const u32x2 b = gb[ai][m];
                    const f32x4 v0 = acc[ai][bj][m][0], v1 = acc[ai][bj][m][1];
                    u32x4 w;
                    w.x = cvt_pk_bf16(v0[0] * sg(F8(b.x, 0), bB0[0]), v0[1] * sg(F8(b.x, 1), bB0[1]));
                    w.y = cvt_pk_bf16(v0[2] * sg(F8(b.x, 2), bB0[2]), v0[3] * sg(F8(b.x, 3), bB0[3]));
                    w.z = cvt_pk_bf16(v1[0] * sg(F8(b.y, 0), bB1[0]), v1[1] * sg(F8(b.y, 1), bB1[1]));
                    w.w = cvt_pk_bf16(v1[2] * sg(F8(b.y, 2), bB1[2]), v1[3] * sg(F8(b.y, 3), bB1[3]));
                    *(u32x4*)(O + row * 4096 + col) = w; } }
    }
};
struct EpiResF32 {
    static constexpr bool PERM = false, HAS_MID = false; static constexpr int NST = 8;
    const float* base; float* out; int ldc;
    __device__ __forceinline__ void operator()(const Acc& acc, const Unit& u, int wr, int wc, int fr, int fq) const {
        const int row0 = u.pm * BM + wr * 64 + fr, col0 = u.pn * BM + wc * 32 + 4 * fq;
#pragma unroll
        for (int ai = 0; ai < 2; ++ai) { f32x4 b[4][2][2];
#pragma unroll
            for (int m = 0; m < 4; ++m) { const size_t off = (size_t)(row0 + ai * HALF + m * 16) * ldc + col0;
#pragma unroll
                for (int bj = 0; bj < 2; ++bj)
#pragma unroll
                    for (int n = 0; n < 2; ++n) b[m][bj][n] = *(const f32x4*)(base + off + bj * HALF + n * 16); }
            asm volatile("" ::: "memory");
#pragma unroll
            for (int m = 0; m < 4; ++m) { const size_t off = (size_t)(row0 + ai * HALF + m * 16) * ldc + col0;
#pragma unroll
                for (int bj = 0; bj < 2; ++bj)
#pragma unroll
                    for (int n = 0; n < 2; ++n) *(f32x4*)(out + off + bj * HALF + n * 16) = b[m][bj][n] + acc[ai][bj][m][n]; }
            asm volatile("" ::: "memory"); }
    }
};
struct EpiRes1 {
    static constexpr bool PERM = true, HAS_MID = false; static constexpr int NST = 8;
    const float* base; bf16_t* xb; float* slots; int ldc;
    __device__ __forceinline__ void operator()(const Acc& acc, const Unit& u, int wr, int wc, int fr, int fq) const {
        const int row0 = u.pm * BM + wr * 64 + fr, col0 = u.pn * BM + wc * 32 + 8 * fq;
#pragma unroll
        for (int ai = 0; ai < 2; ++ai) { f32x4 b[4][2][2];
#pragma unroll
            for (int m = 0; m < 4; ++m) { const size_t off = (size_t)(row0 + ai * HALF + m * 16) * ldc + col0;
#pragma unroll
                for (int bj = 0; bj < 2; ++bj)
#pragma unroll
                    for (int n = 0; n < 2; ++n) b[m][bj][n] = *(const f32x4*)(base + off + bj * HALF + n * 4); }
            asm volatile("" ::: "memory");
#pragma unroll
            for (int m = 0; m < 4; ++m) { const int row = row0 + ai * HALF + m * 16; const size_t off = (size_t)row * ldc + col0; float ss = 0.f;
#pragma unroll
                for (int bj = 0; bj < 2; ++bj) { const f32x4 v0 = b[m][bj][0] + acc[ai][bj][m][0], v1 = b[m][bj][1] + acc[ai][bj][m][1];
                    ss += ((v0[0] * v0[0] + v0[1] * v0[1]) + (v0[2] * v0[2] + v0[3] * v0[3])) + ((v1[0] * v1[0] + v1[1] * v1[1]) + (v1[2] * v1[2] + v1[3] * v1[3]));
                    u32x4 w; w.x = cvt_pk_bf16(v0[0], v0[1]); w.y = cvt_pk_bf16(v0[2], v0[3]); w.z = cvt_pk_bf16(v1[0], v1[1]); w.w = cvt_pk_bf16(v1[2], v1[3]);
                    *(u32x4*)(xb + off + bj * HALF) = w; }
                ss += __shfl_xor(ss, 16); ss += __shfl_xor(ss, 32);
                if (fq == 0) slots[(size_t)row * 64 + 4 * u.pn + wc] = ss; }
            asm volatile("" ::: "memory"); }
    }
};
struct EpiResB {
    static constexpr bool PERM = true, HAS_MID = false; static constexpr int NST = 16;
    bf16_t* xb; int ldc;
    __device__ __forceinline__ void operator()(const Acc& acc, const Unit& u, int wr, int wc, int fr, int fq) const {
        const int row0 = u.pm * BM + wr * 64 + fr, col0 = u.pn * BM + wc * 32 + 8 * fq;
        u32x4 b[2][4][2];
#pragma unroll
        for (int ai = 0; ai < 2; ++ai)
#pragma unroll
            for (int m = 0; m < 4; ++m)
#pragma unroll
                for (int bj = 0; bj < 2; ++bj) b[ai][m][bj] = *(const u32x4*)(xb + (size_t)(row0 + ai * HALF + m * 16) * ldc + col0 + bj * HALF);
        asm volatile("" ::: "memory");
#pragma unroll
        for (int ai = 0; ai < 2; ++ai)
#pragma unroll
            for (int m = 0; m < 4; ++m)
#pragma unroll
                for (int bj = 0; bj < 2; ++bj) { const u32x4 x = b[ai][m][bj]; const f32x4 v0 = acc[ai][bj][m][0], v1 = acc[ai][bj][m][1];
                    u32x4 w; w.x = cvt_pk_bf16(bf_lo(x.x) + v0[0], bf_hi(x.x) + v0[1]); w.y = cvt_pk_bf16(bf_lo(x.y) + v0[2], bf_hi(x.y) + v0[3]);
                    w.z = cvt_pk_bf16(bf_lo(x.z) + v1[0], bf_hi(x.z) + v1[1]); w.w = cvt_pk_bf16(bf_lo(x.w) + v1[2], bf_hi(x.w) + v1[3]);
                    *(u32x4*)(xb + (size_t)(row0 + ai * HALF + m * 16) * ldc + col0 + bj * HALF) = w; }
    }
};
struct EpiSwiGLU {
    static constexpr bool PERM = true, HAS_MID = false; static constexpr int NST = 8;
    bf16_t* O; int ldc; const float* inv;
    __device__ __forceinline__ static float sw(float g, float u) { return g * __builtin_amdgcn_rcpf(1.0f + __expf(-g)) * u; }
    __device__ __forceinline__ void operator()(const Acc& acc, const Unit& u, int wr, int wc, int fr, int fq) const {
        const int row0 = u.pm * BM + wr * 64 + fr, col0 = u.pn * HALF + wc * 32 + 8 * fq;
        float ivs[2][4];
#pragma unroll
        for (int ai = 0; ai < 2; ++ai)
#pragma unroll
            for (int m = 0; m < 4; ++m) ivs[ai][m] = inv[row0 + ai * HALF + m * 16];
        asm volatile("s_waitcnt vmcnt(0)" ::: "memory");
#pragma unroll
        for (int ai = 0; ai < 2; ++ai)
#pragma unroll
            for (int m = 0; m < 4; ++m) { const float iv = ivs[ai][m];
                const f32x4 g0 = acc[ai][0][m][0] * iv, g1 = acc[ai][0][m][1] * iv, u0 = acc[ai][1][m][0] * iv, u1 = acc[ai][1][m][1] * iv;
                u32x4 w;
                w.x = cvt_pk_bf16(sw(g0[0], u0[0]), sw(g0[1], u0[1])); w.y = cvt_pk_bf16(sw(g0[2], u0[2]), sw(g0[3], u0[3]));
                w.z = cvt_pk_bf16(sw(g1[0], u1[0]), sw(g1[1], u1[1])); w.w = cvt_pk_bf16(sw(g1[2], u1[2]), sw(g1[3], u1[3]));
                *(u32x4*)(O + (size_t)(row0 + ai * HALF + m * 16) * ldc + col0) = w; }
    }
};

template <class Epi, class Sched, bool ALIGN_EPI = false, bool SP2 = false, bool RELAX = true, bool FP8 = false, bool MIXED = false, bool SC = false>
__device__ __forceinline__ void gemm_phase(PG8_LAS unsigned char* lds, const Gemm g, const Sched& S, const Epi& E, const int wv) {
    int tid_ = wv * 64 + lane_id(); asm volatile("" : "+v"(tid_));
    const int tid = tid_, wid = __builtin_amdgcn_readfirstlane(tid >> 6), lane = tid & 63, wr = wid >> 2, wc = wid & 3, fr = lane & 15, fq = lane >> 4;
    const int K = g.K, nt = K / BK; int tmid = nt / 2; if constexpr (MIXED) tmid = Epi::KSW;
    unsigned voffA, voffB;
    { int R, C; stage_rc(tid * 16, R, C); const int Rb = Epi::PERM ? ((R & ~31) + perm32(R & 31)) : R;
      voffA = (unsigned)(R * g.lda + C) * 2u; voffB = (unsigned)(Rb * g.ldb + C) * 2u; }
    const size_t d64A = (size_t)64 * g.lda * 2, d64B = (size_t)64 * g.ldb * 2;
    const size_t kstep = (size_t)(BK * 2);
    const size_t hsA = (size_t)HALF * g.lda * 2, hsB = (size_t)HALF * g.ldb * 2;
    const size_t tsA = 2 * hsA, tsB = 2 * hsB;
    const unsigned ldsw = (unsigned)wid * 1024u;
    const int aoff = lds_byte(wr * 64 + fr, fq * 8);
    const int dAB = __builtin_amdgcn_readfirstlane((wc * 4 - wr * 8) * 1024);
#define PG8_SA(b, h) (((b) * 2 + (h)) * HTB)
#define PG8_SB(b, h) ((4 + (b) * 2 + (h)) * HTB)
#define PG8_STAGE(bufoff, gbase, X) do { _Pragma("unroll") for (int _i = 0; _i < 2; ++_i) \
        __builtin_amdgcn_global_load_lds((const unsigned*)((const char*)(gbase) + _i * d64##X + voff##X), (PG8_LAS unsigned*)(lds + (bufoff) + ldsw + _i * 8192), 16, 0, 0); } while (0)
#define PG8_LDA(dst, b, h) do { _Pragma("unroll") for (int m = 0; m < 4; ++m) _Pragma("unroll") for (int k = 0; k < 2; ++k) dst[m][k] = *(const PG8_LAS bf16x8*)(lds + PG8_SA(b, h) + aoff + m * 2048 + k * 1024); } while (0)
#define PG8_LDB(dst, b, h) do { _Pragma("unroll") for (int n = 0; n < 2; ++n) _Pragma("unroll") for (int k = 0; k < 2; ++k) dst[n][k] = *(const PG8_LAS bf16x8*)(lds + PG8_SB(b, h) + dAB + aoff + n * 2048 + k * 1024); } while (0)
    typedef long l64x2 __attribute__((ext_vector_type(2)));
    typedef int i32x4 __attribute__((ext_vector_type(4))); typedef int i32x8 __attribute__((ext_vector_type(8)));
#define PG8_MMA(ai, bj, At, Bt, F8) do { __builtin_amdgcn_s_setprio(1); \
        if constexpr (!(F8)) { _Pragma("unroll") for (int k = 0; k < 2; ++k) _Pragma("unroll") for (int m = 0; m < 4; ++m) _Pragma("unroll") for (int n = 0; n < 2; ++n) \
            acc[ai][bj][m][n] = __builtin_amdgcn_mfma_f32_16x16x32_bf16(Bt[n][k], At[m][k], acc[ai][bj][m][n], 0, 0, 0); } \
        else if constexpr (!SC) { _Pragma("unroll") for (int k = 0; k < 2; ++k) _Pragma("unroll") for (int hh = 0; hh < 2; ++hh) _Pragma("unroll") for (int m = 0; m < 4; ++m) _Pragma("unroll") for (int n = 0; n < 2; ++n) \
            acc[ai][bj][m][n] = __builtin_amdgcn_mfma_f32_16x16x32_fp8_fp8(__builtin_bit_cast(l64x2, Bt[n][k])[hh], __builtin_bit_cast(l64x2, At[m][k])[hh], acc[ai][bj][m][n], 0, 0, 0); } \
        else { _Pragma("unroll") for (int m = 0; m < 4; ++m) _Pragma("unroll") for (int n = 0; n < 2; ++n) { \
            const i32x8 b8_ = __builtin_shufflevector(__builtin_bit_cast(i32x4, Bt[n][0]), __builtin_bit_cast(i32x4, Bt[n][1]), 0, 1, 2, 3, 4, 5, 6, 7); \
            const i32x8 a8_ = __builtin_shufflevector(__builtin_bit_cast(i32x4, At[m][0]), __builtin_bit_cast(i32x4, At[m][1]), 0, 1, 2, 3, 4, 5, 6, 7); \
            acc[ai][bj][m][n] = __builtin_amdgcn_mfma_scale_f32_16x16x128_f8f6f4(b8_, a8_, acc[ai][bj][m][n], 0, 0, 0, 0, 0, 0); } } \
        __builtin_amdgcn_s_setprio(0); } while (0)
#define PG8_WAIT_V(n) asm volatile("s_waitcnt vmcnt(" #n ")" ::: "memory")
#define PG8_WAIT_L(n) asm volatile("s_waitcnt lgkmcnt(" #n ")" ::: "memory")
#define PG8_BAR __builtin_amdgcn_s_barrier()
#define PG8_SCHED __builtin_amdgcn_sched_barrier(0)
    Unit cur, nxt; int ui = 0;
    if (!S.next(0, cur)) return;
    Acc acc;
#pragma unroll
    for (int a = 0; a < 2; ++a)
#pragma unroll
        for (int b = 0; b < 2; ++b)
#pragma unroll
            for (int m = 0; m < 4; ++m)
#pragma unroll
                for (int n = 0; n < 2; ++n) acc[a][b][m][n] = (f32x4){0.f, 0.f, 0.f, 0.f};
    bf16x8 At[4][2], B0[2][2], B1[2][2];
    const char* cA = (const char*)g.A + (size_t)cur.pm * tsA; const char* cB = (const char*)g.Bt + (size_t)cur.pn * tsB;
    S.a_ready(cur);
    if constexpr (SP2) {
        PG8_STAGE(PG8_SB(0, 0), cB, B); PG8_STAGE(PG8_SB(0, 1), cB + hsB, B); PG8_STAGE(PG8_SA(0, 0), cA, A); PG8_STAGE(PG8_SA(0, 1), cA + hsA, A);
        if (wr == 1) PG8_BAR;
        PG8_WAIT_V(2); PG8_BAR;
        PG8_STAGE(PG8_SB(1, 0), cB + kstep, B); PG8_STAGE(PG8_SA(1, 0), cA + kstep, A); PG8_STAGE(PG8_SB(1, 1), cB + hsB + kstep, B);
        PG8_WAIT_V(0); PG8_BAR;
    } else {
        PG8_STAGE(PG8_SB(0, 0), cB, B); PG8_STAGE(PG8_SA(0, 0), cA, A); PG8_STAGE(PG8_SB(0, 1), cB + hsB, B); PG8_STAGE(PG8_SA(0, 1), cA + hsA, A);
        if (wr == 1) PG8_BAR;
        PG8_WAIT_V(4); PG8_BAR;
        PG8_STAGE(PG8_SB(1, 0), cB + kstep, B); PG8_STAGE(PG8_SA(1, 0), cA + kstep, A); PG8_STAGE(PG8_SB(1, 1), cB + hsB + kstep, B);
        PG8_WAIT_V(6); PG8_BAR;
    }
    for (;;) {
        const bool has_next = S.next(ui + 1, nxt);
        const char* nA = has_next ? (const char*)g.A + (size_t)nxt.pm * tsA : cA; const char* nB = has_next ? (const char*)g.Bt + (size_t)nxt.pn * tsB : cB;
        static_assert(SP2, "only the two-blocks-per-barrier K-loop is kept");
#define PG8_TRIP(T, WV, F8) do { const int t = (T); const bool last = (t == nt - 2); \
            const char* a1 = cA + (size_t)(t + 1) * kstep; \
            const char* a2 = last ? nA : cA + (size_t)(t + 2) * kstep; const char* b2 = last ? nB : cB + (size_t)(t + 2) * kstep; \
            const char* a3 = a2 + kstep; const char* b3 = b2 + kstep; \
            if (last && has_next) S.a_ready(nxt); \
            if constexpr (Epi::HAS_MID && !MIXED) { if (t == tmid) E.mid(acc, cur, wr, wc, fr, fq); } \
            PG8_LDB(B0, 0, 0); PG8_LDB(B1, 0, 1); PG8_SCHED; PG8_LDA(At, 0, 0); PG8_STAGE(PG8_SA(1, 1), a1 + hsA, A); \
            asm volatile("s_waitcnt vmcnt(%0)" :: "n"(WV) : "memory"); PG8_WAIT_L(0); PG8_BAR; PG8_MMA(0, 0, At, B0, F8); PG8_MMA(0, 1, At, B1, F8); PG8_BAR; PG8_SCHED; \
            PG8_LDA(At, 0, 1); PG8_STAGE(PG8_SB(0, 0), b2, B); PG8_STAGE(PG8_SB(0, 1), b2 + hsB, B); PG8_STAGE(PG8_SA(0, 0), a2, A); \
            asm volatile("s_waitcnt vmcnt(%0)" :: "n"(WV) : "memory"); PG8_WAIT_L(0); PG8_BAR; PG8_MMA(1, 0, At, B0, F8); PG8_MMA(1, 1, At, B1, F8); PG8_BAR; PG8_SCHED; \
            PG8_LDB(B0, 1, 0); PG8_LDB(B1, 1, 1); PG8_SCHED; PG8_LDA(At, 1, 0); PG8_STAGE(PG8_SA(0, 1), a2 + hsA, A); \
            PG8_WAIT_V(8); PG8_WAIT_L(0); PG8_BAR; PG8_MMA(0, 0, At, B0, F8); PG8_MMA(0, 1, At, B1, F8); PG8_BAR; PG8_SCHED; \
            PG8_LDA(At, 1, 1); PG8_STAGE(PG8_SB(1, 0), b3, B); PG8_STAGE(PG8_SB(1, 1), b3 + hsB, B); PG8_STAGE(PG8_SA(1, 0), a3, A); \
            PG8_WAIT_V(8); PG8_WAIT_L(0); PG8_BAR; PG8_MMA(1, 0, At, B0, F8); PG8_MMA(1, 1, At, B1, F8); PG8_BAR; PG8_SCHED; } while (0)
        if constexpr (MIXED) { static_assert(!RELAX && !FP8, "mixed K-loop: plain waits");
_Pragma("unroll 1") for (int tt = 0; tt < Epi::KSW; tt += 2) PG8_TRIP(tt, 8, false);
            if constexpr (Epi::HAS_MID) E.mid(acc, cur, wr, wc, fr, fq);
_Pragma("unroll 1") for (int tt = Epi::KSW; tt < nt; tt += 2) PG8_TRIP(tt, 8, true); }
        else if constexpr (RELAX) { PG8_TRIP(0, 8 + Epi::NST, FP8); for (int tt = 2; tt < nt; tt += 2) PG8_TRIP(tt, 8, FP8); }
        else { for (int tt = 0; tt < nt; tt += 2) PG8_TRIP(tt, 8, FP8); }
#undef PG8_TRIP
        if constexpr (ALIGN_EPI) { if (wr == 0) PG8_BAR; }
        E(acc, cur, wr, wc, fr, fq); S.done(cur);
        if (!has_next) break;
#pragma unroll
        for (int a = 0; a < 2; ++a)
#pragma unroll
            for (int b = 0; b < 2; ++b)
#pragma unroll
                for (int m = 0; m < 4; ++m)
#pragma unroll
                    for (int n = 0; n < 2; ++n) acc[a][b][m][n] = (f32x4){0.f, 0.f, 0.f, 0.f};
        cur = nxt; cA = nA; cB = nB; ++ui;
        if constexpr (ALIGN_EPI) { if (wr == 1) PG8_BAR; }
    }
    PG8_WAIT_V(0);
    if constexpr (!ALIGN_EPI) { if (wr == 0) PG8_BAR; }
    PG8_BAR;
#undef PG8_SA
#undef PG8_SB
#undef PG8_STAGE
#undef PG8_LDA
#undef PG8_LDB
#undef PG8_MMA
#undef PG8_WAIT_V
#undef PG8_WAIT_L
#undef PG8_BAR
#undef PG8_SCHED
}
}

namespace mla {
using bf16x8 = __attribute__((ext_vector_type(8))) short;
using s16x4  = __attribute__((ext_vector_type(4))) short;
using f32x16 = __attribute__((ext_vector_type(16))) float;
using u32x4  = __attribute__((ext_vector_type(4))) unsigned;
typedef unsigned short bf16_t;
using u32x2 = __attribute__((ext_vector_type(2))) unsigned;
constexpr int NW = 8, QBLK = 32, KVBLK = 64;
constexpr float SCALE = 0.07216878364870323f;
constexpr float THR = 4.f;
constexpr float PLOG2 = 3.f;
constexpr int SDEPTH = 1;
constexpr int KROW = 200;
constexpr int VROW = 72;
constexpr int SHM_V = 128 * VROW, SHM_K = KVBLK * KROW, NVB = 3, SHM_ATTN = NVB * SHM_V + 2 * SHM_K + NW * 64 * 4;
static_assert(SHM_ATTN <= 131072, "attention LDS fits the ring region");
constexpr int LDQ8 = 3072, LDK8 = 2048, LDKR8 = 64, LDKV = 4096, LDO = 8192;
constexpr float OSC = 64.0f;
#define MLA_KSWZ(row, colB) ((row) * 384 + ((colB) ^ ((((row) >> 1) & 7) << 4)))
#define MLA_SBAR() __builtin_amdgcn_sched_barrier(0)
#define MLA_SBM() __builtin_amdgcn_sched_barrier(0x406)
__device__ __forceinline__ int crow(int r, int hi) { return (r & 3) + 8 * (r >> 2) + 4 * hi; }
__device__ __forceinline__ unsigned cvtpk(float lo, float hi) { unsigned r; asm volatile("v_cvt_pk_bf16_f32 %0, %1, %2" : "=v"(r) : "v"(lo), "v"(hi)); return r; }
__device__ __forceinline__ bf16x8 ld8(const bf16_t* p) { return *reinterpret_cast<const bf16x8*>(p); }

constexpr float THR_L2 = THR * 1.4426950408889634f;
template <bool FIRST> __device__ __forceinline__ void partialSM(f32x16& p0, f32x16& p1, f32x16& mneg, float& alpha) {
  float pmax = p0[0];
#pragma unroll
  for (int r = 1; r < 16; ++r) pmax = fmaxf(pmax, p0[r]);
#pragma unroll
  for (int r = 0; r < 16; ++r) pmax = fmaxf(pmax, p1[r]);
  { auto rr = __builtin_amdgcn_permlane32_swap(__float_as_uint(pmax), __float_as_uint(pmax), false, false);
    pmax = fmaxf(__uint_as_float(rr[0]), __uint_as_float(rr[1])); }
  float delta = pmax - PLOG2;
  if (!FIRST && __builtin_expect(__all(delta <= THR_L2), 1)) { alpha = 1.f; }
  else { if (!FIRST) delta = fmaxf(delta, 0.f);
    alpha = __builtin_amdgcn_exp2f(-delta);
#pragma unroll
    for (int r = 0; r < 16; ++r) { p0[r] -= delta; p1[r] -= delta; mneg[r] -= delta; } }
#pragma unroll
  for (int r = 0; r < 16; ++r) p0[r] = __builtin_amdgcn_exp2f(p0[r]);
}
__device__ __forceinline__ void finishSM(f32x16& p0, f32x16& p1, float alpha, float& l_reg, long& pa0, long& pa1, long& pa2, long& pa3) {
#pragma unroll
  for (int r = 0; r < 16; ++r) p1[r] = __builtin_amdgcn_exp2f(p1[r]);
  float ps = 0;
#pragma unroll
  for (int r = 0; r < 16; ++r) ps += p0[r];
#pragma unroll
  for (int r = 0; r < 16; ++r) ps += p1[r];
  { auto rr = __builtin_amdgcn_permlane32_swap(__float_as_uint(ps), __float_as_uint(ps), false, false);
    ps = __uint_as_float(rr[0]) + __uint_as_float(rr[1]); }
  l_reg = l_reg * alpha + ps;
#define MLA_PK4(P, BASE, OUT) do { const unsigned a_ = pg8::pk4_fp8(P[BASE + 0], P[BASE + 1], P[BASE + 2], P[BASE + 3]), b_ = pg8::pk4_fp8(P[BASE + 4], P[BASE + 5], P[BASE + 6], P[BASE + 7]); \
    auto r_ = __builtin_amdgcn_permlane32_swap(a_, b_, false, false); OUT = (long)(((unsigned long long)r_[1] << 32) | (unsigned long long)r_[0]); } while (0)
  MLA_PK4(p0, 0, pa0); MLA_PK4(p0, 8, pa1); MLA_PK4(p1, 0, pa2); MLA_PK4(p1, 8, pa3);
#undef MLA_PK4
}
#define MLA_LDV(addr) (*reinterpret_cast<const volatile __attribute__((address_space(3))) long*>((uintptr_t)(unsigned)(addr)))
typedef long l64x4 __attribute__((ext_vector_type(4))); typedef int i32x8 __attribute__((ext_vector_type(8)));
#define MLA_MMA64(a4, b4, c) __builtin_amdgcn_mfma_scale_f32_32x32x64_f8f6f4(__builtin_bit_cast(i32x8, a4), __builtin_bit_cast(i32x8, b4), c, 0, 0, 0, 0, 0, 0)
struct VFrag { l64x4 v; };
template <int D0> __device__ __forceinline__ void pv_read(VFrag& f, int vb) {
  f.v[0] = MLA_LDV(vb + D0 * 32 * VROW); f.v[1] = MLA_LDV(vb + D0 * 32 * VROW + 16); f.v[2] = MLA_LDV(vb + D0 * 32 * VROW + 32); f.v[3] = MLA_LDV(vb + D0 * 32 * VROW + 48);
}
#define MLA_KLD(T, s_, rb) do { T[0] = MLA_LDV(kb + BUFOFF + (rb) * 32 * KROW + (4 * (s_)) * 16); T[1] = MLA_LDV(kb + BUFOFF + (rb) * 32 * KROW + (4 * (s_) + 1) * 16); \
    T[2] = MLA_LDV(kb + BUFOFF + (rb) * 32 * KROW + (4 * (s_) + 2) * 16); T[3] = MLA_LDV(kb + BUFOFF + (rb) * 32 * KROW + (4 * (s_) + 3) * 16); } while (0)
template <int BUFOFF, bool PFV> __device__ __forceinline__ void qkt(f32x16& p0, f32x16& p1, const f32x16& mneg, int kb, const l64x4* qv, VFrag& fa, VFrag& fb, int vb) {
  l64x4 t0, t1, t2;
  MLA_KLD(t0, 0, 0); MLA_KLD(t1, 0, 1); MLA_KLD(t2, 1, 0);
  p0 = MLA_MMA64(t0, qv[0], mneg); MLA_SBM(); MLA_KLD(t0, 1, 1);
  p1 = MLA_MMA64(t1, qv[0], mneg); MLA_SBM(); MLA_KLD(t1, 2, 0);
  p0 = MLA_MMA64(t2, qv[1], p0); MLA_SBM(); MLA_KLD(t2, 2, 1);
  p1 = MLA_MMA64(t0, qv[1], p1); MLA_SBM(); if constexpr (PFV) pv_read<0>(fa, vb);
  p0 = MLA_MMA64(t1, qv[2], p0); MLA_SBM(); if constexpr (PFV) pv_read<1>(fb, vb);
  p1 = MLA_MMA64(t2, qv[2], p1); MLA_SBM();
}
#undef MLA_KLD
__device__ __forceinline__ void pv_mma(f32x16& od, const VFrag& f, long pa0, long pa1, long pa2, long pa3) {
  const l64x4 pa = {pa0, pa1, pa2, pa3};
  od = MLA_MMA64(pa, f.v, od);
}
__device__ __forceinline__ void pv_d0_pre(f32x16* o, int vb, long pa0, long pa1, long pa2, long pa3, VFrag& fa, VFrag& fb) {
  pv_mma(o[0], fa, pa0, pa1, pa2, pa3); MLA_SBM();
  pv_read<2>(fa, vb);
  pv_mma(o[1], fb, pa0, pa1, pa2, pa3); MLA_SBM();
  pv_read<3>(fb, vb);
  pv_mma(o[2], fa, pa0, pa1, pa2, pa3); MLA_SBM();
  pv_mma(o[3], fb, pa0, pa1, pa2, pa3);
}
__device__ __forceinline__ void pv_d0(f32x16* o, int vb, long pa0, long pa1, long pa2, long pa3) {
  VFrag fa, fb;
  pv_read<0>(fa, vb); pv_read<1>(fb, vb);
  pv_d0_pre(o, vb, pa0, pa1, pa2, pa3, fa, fb);
}
#define MLA_PIN2(a, b) asm volatile("" : "+v"(a), "+v"(b))

__device__ __forceinline__ void attn_unit(const unsigned char* __restrict__ Q8, const unsigned char* __restrict__ K8, const unsigned char* __restrict__ Kr8,
                                          const unsigned char* __restrict__ Vh, unsigned char* __restrict__ Ob, int seq, char* lds, const int wv) {
  const int tid = wv * 64 + pg8::lane_id(), wid = tid >> 6, lane = tid & 63, r32 = lane & 31, hi = lane >> 5;
  char* V_lds = lds; char* K_lds = lds + NVB * SHM_V;
  float* ws = (float*)(lds + NVB * SHM_V + 2 * SHM_K) + wid * 64; float* li_l = ws; float* al_l = ws + 32;
  float l_reg = 0; f32x16 o[4] = {}; l64x4 qv[3]; f32x16 mneg;
#pragma unroll
  for (int r = 0; r < 16; ++r) mneg[r] = PLOG2;
  { int tq = wv * 64 + pg8::lane_id(); asm volatile("" : "+v"(tq));
    const unsigned qoff = (unsigned)((tq >> 6) * QBLK + (tq & 31)) * (unsigned)LDQ8 + (unsigned)(((tq >> 5) & 1) * 8);
    const unsigned char* qp = Q8 + qoff;
#pragma unroll
    for (int d0 = 0; d0 < 12; ++d0) qv[d0 >> 2][d0 & 3] = *(const long*)(qp + d0 * 16); }
  const int vst = (tid >> 2) * VROW + (tid & 3) * 16;
  const int kr = tid >> 3, kc = tid & 7;
  const int kst = kr * KROW + kc * 16, rst = kr * KROW + 128 + kc * 8;
  const int vb0 = (int)(uintptr_t)V_lds + r32 * VROW + hi * 8;
  const int kb = (int)(uintptr_t)K_lds + r32 * KROW + hi * 8;
  struct { u32x4 vs; u32x4 kn; long krp; } sr_[SDEPTH];
  const unsigned offV = (unsigned)tid * 16u, offK = (unsigned)(kr * LDK8 + kc * 16), offR = (unsigned)(kr * LDKR8 + kc * 8);
#define MLA_SLOAD(i, k0) do { const unsigned char* vb_ = Vh + (size_t)(k0) * 128; const unsigned char* kb_ = K8 + (size_t)(k0) * LDK8; const unsigned char* rb_ = Kr8 + (size_t)(k0) * LDKR8; \
    sr_[i].vs = *(const u32x4*)(vb_ + offV); \
    sr_[i].kn = *(const u32x4*)(kb_ + offK); sr_[i].krp = *(const long*)(rb_ + offR); } while (0)
#define MLA_SWRITE(b, vo, i) do { *(u32x2*)(V_lds + (vo) + vst) = (u32x2){sr_[i].vs.x, sr_[i].vs.y}; *(u32x2*)(V_lds + (vo) + vst + 8) = (u32x2){sr_[i].vs.z, sr_[i].vs.w}; \
    *(u32x2*)(K_lds + (b) * SHM_K + kst) = (u32x2){sr_[i].kn.x, sr_[i].kn.y}; *(u32x2*)(K_lds + (b) * SHM_K + kst + 8) = (u32x2){sr_[i].kn.z, sr_[i].kn.w}; \
    *(long*)(K_lds + (b) * SHM_K + rst) = sr_[i].krp; } while (0)
#define MLA_SWAIT() do { if constexpr (SDEPTH == 2) asm volatile("s_waitcnt vmcnt(4)" ::: "memory"); else asm volatile("s_waitcnt vmcnt(0)" ::: "memory"); } while (0)
#define MLA_RESC(a) do { if (__any((a) < 1.f)) { if (hi == 0) al_l[r32] = (a); asm volatile("s_waitcnt lgkmcnt(0)" ::: "memory"); \
    _Pragma("unroll") for (int d = 0; d < 4; ++d) _Pragma("unroll") for (int r = 0; r < 16; ++r) o[d][r] *= al_l[crow(r, hi)]; } } while (0)
  f32x16 pA0, pA1, pB0, pB1; float alA, alB; long pa0, pa1, pa2, pa3; const int NT = seq / KVBLK;
  constexpr int SE = 0, SO = SDEPTH - 1;
  static_assert(SDEPTH == 1, "one tile of register staging");
#define MLA_VNEXT(v) ((v) + SHM_V == NVB * SHM_V ? 0 : (v) + SHM_V)
  MLA_SLOAD(SE, 0); asm volatile("s_waitcnt vmcnt(0)" ::: "memory"); MLA_SWRITE(0, 0, SE); __syncthreads();
  mla::VFrag fa, fb;
  qkt<0, false>(pA0, pA1, mneg, kb, qv, fa, fb, vb0); partialSM<true>(pA0, pA1, mneg, alA);
  MLA_SLOAD(SO, KVBLK);
  MLA_SWAIT(); MLA_SWRITE(1, SHM_V, SO); __syncthreads();
  int vo = 0;
  for (int j = 1; j + 1 < NT; j += 2) {
    { const int vw = MLA_VNEXT(MLA_VNEXT(vo));
      MLA_SBAR(); qkt<SHM_K, true>(pB0, pB1, mneg, kb, qv, fa, fb, vb0 + vo);
      finishSM(pA0, pA1, alA, l_reg, pa0, pa1, pa2, pa3); MLA_SBAR();
      MLA_SLOAD(SO, (j + 1) * KVBLK); MLA_SBAR();
      pv_d0_pre(o, vb0 + vo, pa0, pa1, pa2, pa3, fa, fb); partialSM<false>(pB0, pB1, mneg, alB); MLA_PIN2(pB0, pB1);
      MLA_SWAIT(); MLA_SWRITE(0, vw, SE);
      MLA_RESC(alB); __syncthreads(); vo = MLA_VNEXT(vo); }
    { const int vw = MLA_VNEXT(MLA_VNEXT(vo));
      MLA_SBAR(); qkt<0, true>(pA0, pA1, mneg, kb, qv, fa, fb, vb0 + vo);
      finishSM(pB0, pB1, alB, l_reg, pa0, pa1, pa2, pa3); MLA_SBAR();
      MLA_SLOAD(SE, (j + 2) * KVBLK); MLA_SBAR();
      pv_d0_pre(o, vb0 + vo, pa0, pa1, pa2, pa3, fa, fb); partialSM<false>(pA0, pA1, mneg, alA); MLA_PIN2(pA0, pA1);
      MLA_SWAIT(); MLA_SWRITE(1, vw, SO);
      MLA_RESC(alA); __syncthreads(); vo = MLA_VNEXT(vo); }
  }
  MLA_SBAR(); qkt<SHM_K, true>(pB0, pB1, mneg, kb, qv, fa, fb, vb0 + vo);
  finishSM(pA0, pA1, alA, l_reg, pa0, pa1, pa2, pa3); MLA_SBAR();
  pv_d0_pre(o, vb0 + vo, pa0, pa1, pa2, pa3, fa, fb); partialSM<false>(pB0, pB1, mneg, alB);
  MLA_RESC(alB);
  finishSM(pB0, pB1, alB, l_reg, pa0, pa1, pa2, pa3); MLA_SBAR();
  pv_d0(o, vb0 + MLA_VNEXT(vo), pa0, pa1, pa2, pa3);
#undef MLA_VNEXT
  if (hi == 0) li_l[r32] = l_reg; asm volatile("s_waitcnt lgkmcnt(0)" ::: "memory");
  { int tz = wv * 64 + pg8::lane_id(); asm volatile("" : "+v"(tz));
    const int lane2 = tz & 63, r32b = lane2 & 31, hib = lane2 >> 5, widb = tz >> 6;
    unsigned char* Ow = Ob + (long)(widb * QBLK) * LDO + r32b;
#pragma unroll
    for (int r = 0; r < 16; ++r) { const int orow = crow(r, hib); const float rl = OSC * __builtin_amdgcn_rcpf(li_l[orow]);
#pragma unroll
      for (int d0 = 0; d0 < 4; ++d0) Ow[(long)orow * LDO + d0 * 32] = (unsigned char)(__builtin_amdgcn_cvt_pk_fp8_f32(o[d0][r] * rl, 0.f, 0, false) & 0xff); } }
#undef MLA_SLOAD
#undef MLA_SWRITE
#undef MLA_SWAIT
#undef MLA_RESC
}
}

constexpr int NWAVES = 8;
constexpr int BATCH = 4, SEQ = 4096, DM = 4096, M = BATCH * SEQ;
constexpr int CONV = 2048, QL = 1024, KVL = 512, NH = 16, DFF = 11008;
constexpr int IN_COLS = 15936, NZ = 16128;
constexpr int NQ = 3072, NKV = 4096, NGU = 2 * DFF;
constexpr float RMS_EPS = 1e-6f;

constexpr size_t MiB = 1u << 20;
constexpr size_t WS_CTL = 0, CTL_ZERO_BYTES = 1 * MiB;
constexpr size_t WS_WIN = 1 * MiB;
constexpr size_t WS_WQB = WS_WIN + (size_t)NZ * DM * 2;
constexpr size_t WS_WKVB = WS_WQB + (size_t)NQ * QL * 2;
constexpr size_t WS_WBR = WS_WKVB + (size_t)NKV * KVL * 2;
constexpr size_t WS_WOUT = WS_WBR + (size_t)DM * DM * 2;
constexpr size_t WS_WGU = WS_WOUT + (size_t)DM * DM * 2;
constexpr size_t WS_WDN = WS_WGU + (size_t)NGU * DM * 2;
constexpr size_t WS_RA = WS_WDN + (size_t)DM * DFF * 2;
constexpr size_t WS_ZC = WS_RA + (size_t)M * DM * 2;
constexpr size_t WS_ZS = WS_ZC + (size_t)M * 6144 * 2;
constexpr size_t WS_ZR = WS_ZS + (size_t)M * 1536 * 2;
constexpr size_t WS_ZG = WS_ZR + (size_t)M * 256 * 2;
constexpr size_t WS_H8 = WS_ZG + (size_t)M * 8192 * 2;
constexpr size_t WS_END = WS_H8 + (size_t)M * DM;
constexpr size_t WS_WG8 = WS_WIN;
constexpr size_t WS_KV = WS_ZC, WS_H2 = WS_ZC, WS_ACT = WS_ZC + (size_t)M * DM * 2;
static_assert(WS_ACT + (size_t)M * DFF * 2 <= WS_END, "act overlay fits");
constexpr size_t WS_SLOTS = WS_WIN + 64 * MiB, WS_INV = WS_SLOTS + (size_t)16384 * 64 * 4;
constexpr size_t WS_QN = WS_WIN, WS_KVN = WS_QN + (size_t)M * QL * 2, WS_KR = WS_KVN + (size_t)M * KVL * 2, WS_CS = WS_KR + (size_t)M * 64 * 2;
static_assert(WS_CS + (size_t)M * 64 * 4 <= WS_SLOTS && WS_INV + (size_t)16384 * 4 <= WS_WQB, "P2 / P6 small outputs fit in the dead Win_t region");
constexpr size_t DO_Y = 0, DO_QN = (size_t)M * DM * 2, DO_K8 = DO_QN + (size_t)M * 3072;
static_assert(DO_K8 + (size_t)M * 2048 <= (size_t)M * DM * 4, "d_out scratch fits");
constexpr int CW_TMO = 0, CW_BAR = 4096, CW_RANK = 8192;

constexpr int RING_OFF = 0, RING_BYTES = 131072;
constexpr int LDSCTL_OFF = RING_BYTES, MISC_OFF = LDSCTL_OFF + 320;
constexpr int LDS_BYTES = 147456;

#define GAS __attribute__((address_space(1)))
#define LAS __attribute__((address_space(3)))
typedef unsigned short bf16;
typedef unsigned v4u __attribute__((ext_vector_type(4)));
typedef unsigned v2u __attribute__((ext_vector_type(2)));
typedef float f32x4 __attribute__((ext_vector_type(4)));
typedef GAS unsigned gu32;
#define RLX_AGENT __ATOMIC_RELAXED, __HIP_MEMORY_SCOPE_AGENT
#define LDS_WAIT() asm volatile("s_waitcnt lgkmcnt(0)" ::: "memory")
__device__ __forceinline__ unsigned f2bf(float f) { unsigned u = __builtin_bit_cast(unsigned, f); return (u + 0x7fffu + ((u >> 16) & 1u)) >> 16; }
__device__ __forceinline__ unsigned pk2(float lo, float hi) { return f2bf(lo) | (f2bf(hi) << 16); }
__device__ __forceinline__ float bfl(unsigned w) { return __uint_as_float(w << 16); }
__device__ __forceinline__ float bfh(unsigned w) { return __uint_as_float(w & 0xffff0000u); }

#define XB_TMO      128
#define XB_XCNT(j)  (256  + 64 * (j))
#define XB_XSUB(j)  (1280 + 64 * (j))
#define XB_XGEN(j)  (2304 + 64 * (j))
#define XB_TOP      3328
#define XB_TOPGEN   3392
#define XCD_BAR_WORDS 3456
#define XB_SPIN_CAP (1u << 18)
__device__ __forceinline__ unsigned xb_ld(unsigned* p)              { return __hip_atomic_load(p, __ATOMIC_RELAXED, __HIP_MEMORY_SCOPE_AGENT); }
__device__ __forceinline__ unsigned xb_add(unsigned* p, unsigned v) { return __hip_atomic_fetch_add(p, v, __ATOMIC_RELAXED, __HIP_MEMORY_SCOPE_AGENT); }
__device__ __forceinline__ unsigned xb_xcc_id() { return (unsigned)__builtin_amdgcn_s_getreg((3 << 11) | 20) & 0xFu; }
#define XB_SPIN(cond, bar) do { unsigned _sp = 0; while (cond) { __builtin_amdgcn_s_sleep(1); \
    if ((++_sp & 255u) == 0u) { if (xb_ld(&(bar)[XB_TMO])) break; if (_sp > XB_SPIN_CAP) { atomicAdd(&(bar)[XB_TMO], 1u); break; } } } } while (0)
struct XcdBarrier { unsigned* bar; unsigned x; volatile LAS unsigned* st; };
__device__ __forceinline__ XcdBarrier xcd_barrier_post(unsigned* bar, volatile LAS unsigned* st, const int wv) {
    XcdBarrier b; b.bar = bar; b.x = xb_xcc_id(); b.st = st;
    if (wv == 0 && pg8::lane_id() == 0) (void)xb_add(&bar[XB_XCNT(b.x)], 1u);
    return b;
}
__device__ __forceinline__ void xcd_barrier_complete(unsigned* bar, unsigned x, unsigned& nloc, unsigned& nx) {
    const unsigned G = gridDim.x * gridDim.y * gridDim.z;
    unsigned sum, cnt, mine, sp = 0u;
    for (;;) {
        sum = 0u; cnt = 0u; mine = 0u;
#pragma unroll
        for (unsigned j = 0; j < 16; ++j) { const unsigned c = xb_ld(&bar[XB_XCNT(j)]); sum += c; cnt += (c > 0u) ? 1u : 0u; mine = (j == x) ? c : mine; }
        if (sum == G) break;
        __builtin_amdgcn_s_sleep(1);
        if ((++sp & 255u) == 0u) { if (xb_ld(&bar[XB_TMO])) break; if (sp > XB_SPIN_CAP) { atomicAdd(&bar[XB_TMO], 1u); break; } }
    }
    nloc = mine > 0u ? mine : 1u; nx = cnt > 0u ? cnt : 1u;
}
__device__ __forceinline__ void xcd_barrier(const XcdBarrier& b, const int wv) {
    asm volatile("s_waitcnt vmcnt(0)" ::: "memory");
    __syncthreads();
    if (wv == 0 && pg8::lane_id() == 0) {
        unsigned* bar = b.bar;
        __builtin_amdgcn_s_waitcnt(0);
        unsigned nloc = b.st[0], nx = b.st[1];
        if (nloc == 0u) { xcd_barrier_complete(bar, b.x, nloc, nx); b.st[0] = nloc; b.st[1] = nx; }
        const unsigned old = xb_add(&bar[XB_XSUB(b.x)], 1u);
        const unsigned gen = old / nloc;
        if (old + 1u == (gen + 1u) * nloc) {
            __builtin_amdgcn_fence(__ATOMIC_RELEASE, "agent");
            asm volatile("s_waitcnt vmcnt(0)" ::: "memory");
            const unsigned og = xb_add(&bar[XB_TOP], 1u);
            const unsigned tg = og / nx;
            if (og + 1u == (tg + 1u) * nx) xb_add(&bar[XB_TOPGEN], 1u);
            else XB_SPIN(xb_ld(&bar[XB_TOPGEN]) == tg, bar);
            __builtin_amdgcn_fence(__ATOMIC_ACQUIRE, "agent");
            xb_add(&bar[XB_XGEN(b.x)], 1u);
            asm volatile("s_waitcnt vmcnt(0)" ::: "memory");
        } else {
            XB_SPIN(xb_ld(&bar[XB_XGEN(b.x)]) == gen, bar);
            __builtin_amdgcn_fence(__ATOMIC_ACQUIRE, "agent");
            asm volatile("s_waitcnt vmcnt(0)" ::: "memory");
        }
    }
    __syncthreads();
}

__device__ __forceinline__ float wave_sum(float v) {
#pragma unroll
    for (int o = 1; o < 64; o <<= 1) v += __shfl_xor(v, o);
    return v;
}
enum { J_IN = 0, J_QB, J_KVB, J_BR, J_OUT, J_GU, J_DN };
template <int JOB> __device__ __forceinline__ int xmap(int n, int aux) {
    if constexpr (JOB == J_IN) return n;
    else if constexpr (JOB == J_QB) { const int h = n / 192, r = n % 192; return r < 128 ? h * 128 + r : 2048 + (h >> 2) * 256 + ((r - 128) >> 5) * 128 + (h & 3) * 32 + (r & 31); }
    else if constexpr (JOB == J_GU) return (n >> 7) * 256 + aux * 128 + (n & 127);
    else return n;
}
template <int JOB> __device__ __forceinline__ void xpose_tile(const float* W, int Nsrc, int tile, bf16* dst, int ldd, int kofs, int aux, const float* gk, int lane) {
    const int ntn = Nsrc >> 6, k0 = (tile / ntn) << 6, n0 = (tile % ntn) << 6, kb = lane >> 4, nq = lane & 15;
    const GAS f32x4* src = (const GAS f32x4*)(W + (size_t)(k0 + 16 * kb) * Nsrc + n0 + 4 * nq);
    f32x4 v[16];
#pragma unroll
    for (int i = 0; i < 16; ++i) v[i] = src[(size_t)i * (Nsrc >> 2)];
    if (gk) { const GAS f32x4* gp = (const GAS f32x4*)(gk + k0 + 16 * kb);
#pragma unroll
        for (int q = 0; q < 4; ++q) { const f32x4 g4 = gp[q]; v[4 * q] = v[4 * q] * g4.x; v[4 * q + 1] = v[4 * q + 1] * g4.y; v[4 * q + 2] = v[4 * q + 2] * g4.z; v[4 * q + 3] = v[4 * q + 3] * g4.w; } }
    const int nd = xmap<JOB>(n0 + 4 * nq, aux);
    bf16* drow = dst + (size_t)nd * ldd + kofs + k0 + 16 * kb;
#pragma unroll
    for (int j = 0; j < 4; ++j) { v4u a, b;
        a.x = pk2(v[0][j], v[1][j]); a.y = pk2(v[2][j], v[3][j]); a.z = pk2(v[4][j], v[5][j]); a.w = pk2(v[6][j], v[7][j]);
        b.x = pk2(v[8][j], v[9][j]); b.y = pk2(v[10][j], v[11][j]); b.z = pk2(v[12][j], v[13][j]); b.w = pk2(v[14][j], v[15][j]);
        GAS v4u* o = (GAS v4u*)(drow + (size_t)j * ldd); o[0] = a; o[1] = b; }
}
enum { J8_IN = 0, J8_QB, J8_KVB };
template <int JOB8> __device__ __forceinline__ int xmap8(int n) {
    if constexpr (JOB8 == J8_IN) return n >= 7744 ? n - 7744 : 8192 + (n - 6144);
    else if constexpr (JOB8 == J8_QB) return xmap<J_QB>(n, 0);
    else return n;
}
template <int JOB8> __device__ __forceinline__ void xpose_tile_fp8(const float* W, int Nsrc, int k0, int n0, unsigned char* dst, int ldd, float wsc, int lane) {
    const int kb = lane >> 4, nq = lane & 15;
    const GAS f32x4* src = (const GAS f32x4*)(W + (size_t)(k0 + 16 * kb) * Nsrc + n0 + 4 * nq);
    f32x4 v[16];
#pragma unroll
    for (int i = 0; i < 16; ++i) v[i] = src[(size_t)i * (Nsrc >> 2)] * wsc;
    unsigned char* drow = dst + (size_t)xmap8<JOB8>(n0 + 4 * nq) * ldd + k0 + 16 * kb;
#pragma unroll
    for (int j = 0; j < 4; ++j) { v4u a;
        a.x = pg8::pk4_fp8(v[0][j], v[1][j], v[2][j], v[3][j]); a.y = pg8::pk4_fp8(v[4][j], v[5][j], v[6][j], v[7][j]);
        a.z = pg8::pk4_fp8(v[8][j], v[9][j], v[10][j], v[11][j]); a.w = pg8::pk4_fp8(v[12][j], v[13][j], v[14][j], v[15][j]);
        *(GAS v4u*)(drow + (size_t)j * ldd) = a; }
}
template <bool OUTF> __device__ __forceinline__ void rms_row4096(const float* xrow, const float* g, void* orow, int lane) {
    const GAS f32x4* xr = (const GAS f32x4*)xrow + lane;
    f32x4 v[16]; float s = 0.f;
#pragma unroll
    for (int j = 0; j < 16; ++j) { v[j] = xr[64 * j]; s += (v[j].x * v[j].x + v[j].y * v[j].y) + (v[j].z * v[j].z + v[j].w * v[j].w); }
    const float inv = 1.0f / sqrtf(wave_sum(s) * (1.f / 4096.f) + RMS_EPS);
    const GAS f32x4* gr = (const GAS f32x4*)g + lane;
#pragma unroll
    for (int j = 0; j < 16; ++j) { const f32x4 gv = gr[64 * j]; const f32x4 o = v[j] * inv * gv;
        if constexpr (OUTF) ((GAS f32x4*)orow + lane)[64 * j] = o;
        else ((GAS unsigned long long*)orow + lane)[64 * j] = (unsigned long long)pk2(o.x, o.y) | ((unsigned long long)pk2(o.z, o.w) << 32); }
}

struct Args { const float* in[17]; float* out; unsigned char* ws; int ph_lo, ph_hi; };
static_assert(sizeof(Args) == 17 * 8 + 8 + 8 + 8, "no padding in Args");
constexpr int N_PHASES = 11;

__global__ void __launch_bounds__(NWAVES * 64, 2) mega_fwd(Args args) {
    extern __shared__ __attribute__((aligned(16))) unsigned char lds[];
    LAS unsigned char* L = (LAS unsigned char*)lds;
    volatile LAS unsigned* MISC = (volatile LAS unsigned*)(L + MISC_OFF);
    const int tid = threadIdx.x, lane = tid & 63, wave = __builtin_amdgcn_readfirstlane(tid >> 6);
    const int G = gridDim.x; const int bx = blockIdx.x; const int vcu = (G % 8 == 0) ? (bx % 8) * (G / 8) + bx / 8 : bx;
    unsigned char* ws = args.ws;
    gu32* ctl = (gu32*)(ws + WS_CTL);
    const float* x = args.in[0]; const int* positions = (const int*)args.in[1]; const float* g_mix = args.in[2]; const float* w_in = args.in[3];
    const float* b_gate = args.in[4]; const float* conv_w = args.in[5]; const float* g_q_a = args.in[6]; const float* w_q_b = args.in[7];
    const float* g_kv_a = args.in[8]; const float* w_kv_b = args.in[9]; const float* w_branch = args.in[10]; const float* w_out = args.in[11];
    const float* g_ffn = args.in[12]; const float* w_ffn_gate = args.in[13]; const float* w_ffn_up = args.in[14]; const float* w_ffn_down = args.in[15];
    const float* g_final = args.in[16];
    float* out = args.out; unsigned char* ob = (unsigned char*)args.out;
    unsigned char* Wg8_t = ws + WS_WG8; unsigned char* H8 = ws + WS_H8;
    bf16* Win_t = (bf16*)(ws + WS_WIN + 64 * MiB);
    bf16* Wbr_t = (bf16*)(ws + WS_WBR);
    bf16* Wout_t = (bf16*)(ws + WS_WOUT); bf16* Wgu_t = (bf16*)(ws + WS_WGU); bf16* Wdn_t = (bf16*)(ws + WS_WDN);
    bf16* RA = (bf16*)(ws + WS_RA); bf16* zc = (bf16*)(ws + WS_ZC); bf16* zs = (bf16*)(ws + WS_ZS); bf16* zr = (bf16*)(ws + WS_ZR); bf16* zg = (bf16*)(ws + WS_ZG);
    unsigned char* V8T = ws + WS_KV; bf16* H2 = (bf16*)(ws + WS_H2); bf16* ACT = (bf16*)(ws + WS_ACT);
    unsigned char* QN8 = ws + WS_QN; unsigned char* KVN8 = ws + WS_KVN; float* CS = (float*)(ws + WS_CS);
    unsigned char* Wqb8_t = ws + WS_WQB; unsigned char* Wkvb8_t = ws + WS_WKVB;
    float* SLOTS = (float*)(ws + WS_SLOTS); float* INV = (float*)(ws + WS_INV);
    bf16* Y = (bf16*)(ob + DO_Y); unsigned char* Q8 = ob + DO_QN; unsigned char* K8n = ob + DO_K8; unsigned char* KR8 = ws + WS_KR;

    for (int u = tid; u < (LDS_BYTES - LDSCTL_OFF) / 4; u += NWAVES * 64) ((LAS unsigned*)(L + LDSCTL_OFF))[u] = 0u;
    __syncthreads();
    XcdBarrier bar; bar.bar = (unsigned*)(ctl + CW_BAR); bar.x = 0; bar.st = nullptr;
    if (!MK_PER_PHASE) bar = xcd_barrier_post((unsigned*)(ctl + CW_BAR), MISC + 8, wave);
    const int lo = args.ph_lo, hi = args.ph_hi;
#define IN(k) (lo <= (k) && (k) < hi)
#define SEAM(k) do { if (IN(k) && IN((k) + 1)) xcd_barrier(bar, wave); } while (0)
    const int gw = vcu * NWAVES + wave, NGW = G * NWAVES;
    if (!MK_PER_PHASE && tid == 0) { const unsigned xcc_ = xb_xcc_id(); MISC[16] = xcc_; MISC[17] = __hip_atomic_fetch_add((unsigned*)(ctl + CW_RANK + 64 * xcc_), 1u, RLX_AGENT); }

    if (IN(0)) for (int rep_ = 0; rep_ < DUP(0); ++rep_) {
        int tz_ = pg8::lane_id(); asm volatile("" : "+v"(tz_)); const int lane = tz_;
        constexpr int T_IN = (DM / 64) * (IN_COLS / 64), T_BR = (CONV / 64) * (DM / 64), T_G = (DM / 64) * (DFF / 64);
        constexpr int T_QB = (QL / 64) * (NQ / 64), T_KVB = (KVL / 64) * (NKV / 64), T_OUT = (DM / 64) * (DM / 64), T_DN = (DFF / 64) * (DM / 64);
        constexpr int NT0 = T_IN + 2 * T_G + T_QB + T_KVB;
        for (int it = gw; it < NT0; it += NGW) {
            int r = it;
            if (r < T_IN) { const int ntn_ = IN_COLS >> 6, n0_ = (r % ntn_) << 6;
                if (n0_ >= 6144) xpose_tile_fp8<J8_IN>(w_in, IN_COLS, (r / ntn_) << 6, n0_, Wg8_t, DM, 64.0f, lane);
                else xpose_tile<J_IN>(w_in, IN_COLS, r, Win_t, DM, 0, 0, nullptr, lane);
                continue; } r -= T_IN;
            if (r < 2 * T_G) { const int up = r / T_G; r -= up * T_G; xpose_tile<J_GU>(up ? w_ffn_up : w_ffn_gate, DFF, r, Wgu_t, DM, 0, up, g_ffn, lane); continue; } r -= 2 * T_G;
            if (r < T_QB) { const int ntn_ = NQ >> 6; xpose_tile_fp8<J8_QB>(w_q_b, NQ, (r / ntn_) << 6, (r % ntn_) << 6, Wqb8_t, QL, 32.0f, lane); continue; } r -= T_QB;
            { const int ntn_ = NKV >> 6; xpose_tile_fp8<J8_KVB>(w_kv_b, NKV, (r / ntn_) << 6, (r % ntn_) << 6, Wkvb8_t, KVL, 16.0f, lane); }
        }
        for (int rr = gw; rr < 192; rr += NGW) { GAS v4u* p = (GAS v4u*)(Wg8_t + (size_t)(9792 + rr) * DM) + lane;
#pragma unroll
            for (int j = 0; j < 4; ++j) p[64 * j] = (v4u){0u, 0u, 0u, 0u}; }
        for (int m = gw; m < M; m += NGW) {
            const GAS f32x4* xr = (const GAS f32x4*)(x + (size_t)m * DM) + lane; f32x4 v[16]; float s = 0.f;
#pragma unroll
            for (int j = 0; j < 16; ++j) { v[j] = xr[64 * j]; s += (v[j].x * v[j].x + v[j].y * v[j].y) + (v[j].z * v[j].z + v[j].w * v[j].w); }
            const float inv = 1.0f / sqrtf(wave_sum(s) * (1.f / 4096.f) + RMS_EPS);
            const GAS f32x4* gr = (const GAS f32x4*)g_mix + lane;
            GAS unsigned long long* ob_ = (GAS unsigned long long*)(RA + (size_t)m * DM) + lane; GAS unsigned* o8_ = (GAS unsigned*)(H8 + (size_t)m * DM) + lane;
#pragma unroll
            for (int j = 0; j < 16; ++j) { const f32x4 o = v[j] * inv * gr[64 * j];
                ob_[64 * j] = (unsigned long long)pk2(o.x, o.y) | ((unsigned long long)pk2(o.z, o.w) << 32); o8_[64 * j] = pg8::pk4_fp8(o.x, o.y, o.z, o.w); } }
    }
    SEAM(0);
    int cx = bx, vcx = vcu;
    if (!MK_PER_PHASE && lo == 0 && hi > 1) {
        bool uni = (G % 8 == 0);
        for (int j = 0; j < 16; ++j) { const unsigned cnt_ = __hip_atomic_load((unsigned*)(ctl + CW_BAR) + XB_XCNT(j), RLX_AGENT); uni = uni && (j < 8 ? cnt_ == (unsigned)(G / 8) : cnt_ == 0u); }
        if (uni) { const int xcc_ = (int)MISC[16], rk_ = (int)MISC[17]; cx = rk_ * 8 + xcc_; vcx = xcc_ * (G / 8) + rk_; }
    }
    cx = __builtin_amdgcn_readfirstlane(cx); vcx = __builtin_amdgcn_readfirstlane(vcx);

    if (IN(1)) for (int rep_ = 0; rep_ < DUP(1); ++rep_) {
        { pg8::Gemm g{(const bf16*)H8, (const bf16*)Wg8_t, M, 8192, DM / 2, DM / 2, DM / 2}; pg8::StaticOrder S; S.init(M, 8192, G, cx);
          pg8::EpiG8 E{(unsigned char*)zg, 1.0f / 64.0f};
          pg8::gemm_phase<pg8::EpiG8, pg8::StaticOrder, true, true, false, true, false, true>(L + RING_OFF, g, S, E, wave); }
        { pg8::Gemm g{(const bf16*)H8, (const bf16*)(Wg8_t + (size_t)8192 * DM), M, 1792, DM / 2, DM / 2, DM / 2}; pg8::StaticOrder S; S.init(M, 1792, G, cx);
          pg8::EpiZ8 E{zg, zs, zr, 1.0f / 64.0f};
          pg8::gemm_phase<pg8::EpiZ8, pg8::StaticOrder, true, true, false, true, false, true>(L + RING_OFF, g, S, E, wave); }
        { pg8::Gemm g{RA, Win_t, M, 6144, DM, DM, DM}; pg8::StaticOrder S; S.init(M, 6144, G, cx);
          pg8::EpiBf16 E{zc, 6144, 1.0f};
          pg8::gemm_phase<pg8::EpiBf16, pg8::StaticOrder, true, true>(L + RING_OFF, g, S, E, wave); }
        { constexpr int T_BR = (CONV / 64) * (DM / 64), T_OUT = (DM / 64) * (DM / 64); const int rem = ((M / 256) * (1792 / 256)) % G, first = rem, nidle = G - first;
          int tz = pg8::lane_id(); asm volatile("" : "+v"(tz)); const int lane = tz;
          if (cx >= first) for (int it = (cx - first) * NWAVES + wave; it < 2 * T_BR + T_OUT; it += nidle * NWAVES) { int r = it;
              if (r < T_BR) { xpose_tile<J_BR>(w_branch, DM, r, Wbr_t, DM, 0, 0, nullptr, lane); continue; } r -= T_BR;
              if (r < T_BR) { xpose_tile_fp8<J8_KVB>(w_branch + (size_t)CONV * DM, DM, (r / (DM >> 6)) << 6, (r % (DM >> 6)) << 6, (unsigned char*)Wbr_t + 4096, DM * 2, 32.0f, lane); continue; } r -= T_BR;
              xpose_tile<J_OUT>(w_out, DM, r, Wout_t, DM, 0, 0, nullptr, lane); } }
    }
    SEAM(1);

    if (IN(2)) for (int rep_ = 0; rep_ < DUP(2); ++rep_) {
        int tz_ = pg8::lane_id(); asm volatile("" : "+v"(tz_)); const int lane = tz_;
        for (int m = gw; m < M; m += NGW) {
            const bf16* zrow = zs + (size_t)m * 1536;
            const v4u q0 = *(const GAS v4u*)(zrow + lane * 8), q1 = *(const GAS v4u*)(zrow + 512 + lane * 8), k0 = *(const GAS v4u*)(zrow + 1024 + lane * 8);
            const unsigned short rraw = zr[(size_t)m * 256 + lane];
            const int pos = positions[m];
            float qa[16], ka[8];
            qa[0] = bfl(q0.x); qa[1] = bfh(q0.x); qa[2] = bfl(q0.y); qa[3] = bfh(q0.y); qa[4] = bfl(q0.z); qa[5] = bfh(q0.z); qa[6] = bfl(q0.w); qa[7] = bfh(q0.w);
            qa[8] = bfl(q1.x); qa[9] = bfh(q1.x); qa[10] = bfl(q1.y); qa[11] = bfh(q1.y); qa[12] = bfl(q1.z); qa[13] = bfh(q1.z); qa[14] = bfl(q1.w); qa[15] = bfh(q1.w);
            ka[0] = bfl(k0.x); ka[1] = bfh(k0.x); ka[2] = bfl(k0.y); ka[3] = bfh(k0.y); ka[4] = bfl(k0.z); ka[5] = bfh(k0.z); ka[6] = bfl(k0.w); ka[7] = bfh(k0.w);
            float sq = 0.f, sk = 0.f;
#pragma unroll
            for (int j = 0; j < 16; ++j) sq += qa[j] * qa[j];
#pragma unroll
            for (int j = 0; j < 8; ++j) sk += ka[j] * ka[j];
            const float iq = 1.0f / sqrtf(wave_sum(sq) * (1.f / 1024.f) + RMS_EPS), ik = 1.0f / sqrtf(wave_sum(sk) * (1.f / 512.f) + RMS_EPS);
            const f32x4 ga0 = *(const GAS f32x4*)(g_q_a + lane * 8), ga1 = *(const GAS f32x4*)(g_q_a + lane * 8 + 4), gb0 = *(const GAS f32x4*)(g_q_a + 512 + lane * 8), gb1 = *(const GAS f32x4*)(g_q_a + 512 + lane * 8 + 4);
            const f32x4 gk0 = *(const GAS f32x4*)(g_kv_a + lane * 8), gk1 = *(const GAS f32x4*)(g_kv_a + lane * 8 + 4);
            v2u o;
            o.x = pg8::pk4_fp8(qa[0] * iq * ga0.x, qa[1] * iq * ga0.y, qa[2] * iq * ga0.z, qa[3] * iq * ga0.w); o.y = pg8::pk4_fp8(qa[4] * iq * ga1.x, qa[5] * iq * ga1.y, qa[6] * iq * ga1.z, qa[7] * iq * ga1.w);
            *(GAS v2u*)(QN8 + (size_t)m * QL + lane * 8) = o;
            o.x = pg8::pk4_fp8(qa[8] * iq * gb0.x, qa[9] * iq * gb0.y, qa[10] * iq * gb0.z, qa[11] * iq * gb0.w); o.y = pg8::pk4_fp8(qa[12] * iq * gb1.x, qa[13] * iq * gb1.y, qa[14] * iq * gb1.z, qa[15] * iq * gb1.w);
            *(GAS v2u*)(QN8 + (size_t)m * QL + 512 + lane * 8) = o;
            o.x = pg8::pk4_fp8(ka[0] * ik * gk0.x, ka[1] * ik * gk0.y, ka[2] * ik * gk0.z, ka[3] * ik * gk0.w); o.y = pg8::pk4_fp8(ka[4] * ik * gk1.x, ka[5] * ik * gk1.y, ka[6] * ik * gk1.z, ka[7] * ik * gk1.w);
            *(GAS v2u*)(KVN8 + (size_t)m * KVL + lane * 8) = o;
            const int i = lane & 31;
            const float invf = powf(10000.0f, -(float)(2 * i) * (1.0f / 64.0f));
            const float ang = (float)pos * invf; float sn, cn; sincosf(ang, &sn, &cn);
            const float mine = __uint_as_float(((unsigned)rraw) << 16), other = __shfl_xor(mine, 32);
            const float rot = lane < 32 ? (mine * cn - other * sn) : (other * sn + mine * cn);
            KR8[(size_t)m * 64 + lane] = (unsigned char)(__builtin_amdgcn_cvt_pk_fp8_f32(rot, 0.f, 0, false) & 0xff);
            if (lane < 32) { float2 c2; c2.x = cn; c2.y = sn; *(float2*)(CS + (size_t)m * 64 + 2 * i) = c2; }
        }
        for (int it = gw; it < (M / 32) * 4; it += NGW) {
            const int r0 = (it >> 2) * 32, c0 = (it & 3) * 512 + lane * 8;
            float w0[8], w1[8], w2[8];
#pragma unroll
            for (int j = 0; j < 8; ++j) { w0[j] = conv_w[c0 + j]; w1[j] = conv_w[CONV + c0 + j]; w2[j] = conv_w[2 * CONV + c0 + j]; }
            float up[8], uc[8], un[8];
#define CONV_U(dst, row) do { const v4u cc = *(const GAS v4u*)(zc + (size_t)(row) * 6144 + 2048 + c0), ch = *(const GAS v4u*)(zc + (size_t)(row) * 6144 + 4096 + c0); \
            dst[0] = bfl(cc.x) * bfl(ch.x); dst[1] = bfh(cc.x) * bfh(ch.x); dst[2] = bfl(cc.y) * bfl(ch.y); dst[3] = bfh(cc.y) * bfh(ch.y); \
            dst[4] = bfl(cc.z) * bfl(ch.z); dst[5] = bfh(cc.z) * bfh(ch.z); dst[6] = bfl(cc.w) * bfl(ch.w); dst[7] = bfh(cc.w) * bfh(ch.w); } while (0)
            if ((r0 & (SEQ - 1)) != 0) CONV_U(up, r0 - 1); else {
#pragma unroll
                for (int j = 0; j < 8; ++j) up[j] = 0.f; }
            CONV_U(uc, r0);
            const bool tail_ok = ((r0 + 32) & (SEQ - 1)) != 0;
#pragma unroll 4
            for (int r = r0; r < r0 + 32; ++r) {
                if (r + 1 < r0 + 32 || tail_ok) CONV_U(un, r + 1); else {
#pragma unroll
                    for (int j = 0; j < 8; ++j) un[j] = 0.f; }
                const v4u cb = *(const GAS v4u*)(zc + (size_t)r * 6144 + c0);
                float yv[8];
#pragma unroll
                for (int j = 0; j < 8; ++j) yv[j] = w0[j] * up[j] + w1[j] * uc[j] + w2[j] * un[j];
                v4u o; o.x = pk2(bfl(cb.x) * yv[0], bfh(cb.x) * yv[1]); o.y = pk2(bfl(cb.y) * yv[2], bfh(cb.y) * yv[3]); o.z = pk2(bfl(cb.z) * yv[4], bfh(cb.z) * yv[5]); o.w = pk2(bfl(cb.w) * yv[6], bfh(cb.w) * yv[7]);
                *(GAS v4u*)(Y + (size_t)r * DM + c0) = o;
#pragma unroll
                for (int j = 0; j < 8; ++j) { up[j] = uc[j]; uc[j] = un[j]; }
            }
#undef CONV_U
        }
    }
    SEAM(2);

    if (IN(3)) for (int rep_ = 0; rep_ < DUP(3); ++rep_) {
        { pg8::Gemm g{(const bf16*)QN8, (const bf16*)Wqb8_t, M, NQ, QL / 2, QL / 2, QL / 2}; pg8::StaticOrder S; S.init(M, NQ, G, cx);
          pg8::EpiQ E{Q8, CS, mla::SCALE * 1.4426950408889634f / 32.0f};
          pg8::gemm_phase<pg8::EpiQ, pg8::StaticOrder, true, true, false, true>(L + RING_OFF, g, S, E, wave); }
        { pg8::Gemm g{(const bf16*)KVN8, (const bf16*)Wkvb8_t, M, NKV, KVL / 2, KVL / 2, KVL / 2}; pg8::StaticOrder S; S.init(M, NKV, G, cx);
          pg8::EpiKV E{K8n, V8T, 1.0f / 16.0f};
          pg8::gemm_phase<pg8::EpiKV, pg8::StaticOrder, true, true, false, true>(L + RING_OFF, g, S, E, wave); }
    }
    SEAM(3);

    if (IN(4)) for (int rep_ = 0; rep_ < DUP(4); ++rep_) {
        for (int i = 0; ; ++i) {
            const int u = i * G + vcx; if (u >= BATCH * NH * (SEQ / 256)) break;
            const int bh = u >> 4, qb = u & 15, b = bh >> 4, h = bh & 15;
            const size_t q0 = (size_t)b * SEQ + (size_t)qb * 256, kbase = (size_t)b * SEQ;
            mla::attn_unit(Q8 + q0 * 3072 + h * 192, K8n + kbase * 2048 + h * 128, KR8 + kbase * 64, V8T + (size_t)bh * (64 * 8192),
                           (unsigned char*)Y + q0 * (DM * 2) + 4096 + h * 128, SEQ, (char*)lds + RING_OFF, wave);
            __syncthreads();
        }
    }
    SEAM(4);

    if (IN(5)) for (int rep_ = 0; rep_ < DUP(5); ++rep_) {
        pg8::Gemm g{Y, Wbr_t, M, DM, 3072, DM, DM}; pg8::StaticOrder S; S.init(M, DM, G, cx);
        pg8::EpiGate E{(const unsigned char*)zg, b_gate, RA};
        pg8::gemm_phase<pg8::EpiGate, pg8::StaticOrder, true, true, false, false, true, true>(L + RING_OFF, g, S, E, wave);
    }
    SEAM(5);

    if (IN(6)) for (int rep_ = 0; rep_ < DUP(6); ++rep_) {
        pg8::Gemm g{RA, Wout_t, M, DM, DM, DM, DM}; pg8::StaticOrder S; S.init(M, DM, G, cx);
        pg8::EpiRes1 E{x, H2, SLOTS, DM};
        pg8::gemm_phase<pg8::EpiRes1, pg8::StaticOrder, true, true>(L + RING_OFF, g, S, E, wave);
    }
    SEAM(6);

    if (IN(7)) for (int rep_ = 0; rep_ < DUP(7); ++rep_) {
        int tz_ = pg8::lane_id(); asm volatile("" : "+v"(tz_)); const int lane = tz_;
        for (int m = gw; m < M; m += NGW) { const float s = wave_sum(SLOTS[(size_t)m * 64 + lane]); if (lane == 0) INV[m] = 1.0f / sqrtf(s * (1.f / 4096.f) + RMS_EPS); }
    }
    SEAM(7);

    if (IN(8)) for (int rep_ = 0; rep_ < DUP(8); ++rep_) {
        pg8::Gemm g{H2, Wgu_t, M, NGU, DM, DM, DM}; pg8::StaticOrder S; S.init(M, NGU, G, cx);
        pg8::EpiSwiGLU E{ACT, DFF, INV};
        pg8::gemm_phase<pg8::EpiSwiGLU, pg8::StaticOrder, true, true>(L + RING_OFF, g, S, E, wave);
        { constexpr int T_DN = (DFF / 64) * (DM / 64); const int rem = S.nwg % G, first = rem, nidle = G - first;
          int tz_ = pg8::lane_id(); asm volatile("" : "+v"(tz_)); const int lane = tz_;
          if (cx >= first) for (int it = (cx - first) * NWAVES + wave; it < T_DN; it += nidle * NWAVES) xpose_tile<J_DN>(w_ffn_down, DM, it, Wdn_t, DFF, 0, 0, nullptr, lane); }
    }
    SEAM(8);

    if (IN(9)) for (int rep_ = 0; rep_ < DUP(9); ++rep_) {
        pg8::Gemm g{ACT, Wdn_t, M, DM, DFF, DFF, DFF}; pg8::StaticOrder S; S.init(M, DM, G, cx, 4);
        pg8::EpiResB E{H2, DM};
        pg8::gemm_phase<pg8::EpiResB, pg8::StaticOrder, true, true>(L + RING_OFF, g, S, E, wave);
    }
    SEAM(9);

    if (IN(10)) for (int rep_ = 0; rep_ < DUP(10); ++rep_) {
        int tz_ = pg8::lane_id(); asm volatile("" : "+v"(tz_)); const int lane = tz_;
        for (int m = gw; m < M; m += NGW) {
            const GAS v4u* xr = (const GAS v4u*)(H2 + (size_t)m * DM) + lane; v4u v[8]; float s = 0.f;
#pragma unroll
            for (int j = 0; j < 8; ++j) { v[j] = xr[64 * j];
                s += (bfl(v[j].x) * bfl(v[j].x) + bfh(v[j].x) * bfh(v[j].x)) + (bfl(v[j].y) * bfl(v[j].y) + bfh(v[j].y) * bfh(v[j].y))
                   + (bfl(v[j].z) * bfl(v[j].z) + bfh(v[j].z) * bfh(v[j].z)) + (bfl(v[j].w) * bfl(v[j].w) + bfh(v[j].w) * bfh(v[j].w)); }
            const float inv = 1.0f / sqrtf(wave_sum(s) * (1.f / 4096.f) + RMS_EPS);
            const GAS f32x4* gr = (const GAS f32x4*)g_final + 2 * lane; GAS f32x4* orow = (GAS f32x4*)(out + (size_t)m * DM) + 2 * lane;
#pragma unroll
            for (int j = 0; j < 8; ++j) { const f32x4 g0 = gr[128 * j], g1 = gr[128 * j + 1];
                orow[128 * j] = (f32x4){bfl(v[j].x) * inv * g0.x, bfh(v[j].x) * inv * g0.y, bfl(v[j].y) * inv * g0.z, bfh(v[j].y) * inv * g0.w};
                orow[128 * j + 1] = (f32x4){bfl(v[j].z) * inv * g1.x, bfh(v[j].z) * inv * g1.y, bfl(v[j].w) * inv * g1.z, bfh(v[j].w) * inv * g1.w}; }
        }
    }
#undef IN
#undef SEAM
}

extern "C" void kernel_launch(void* const* d_in, const int* in_sizes, int n_in, void* d_out, int out_size, void* d_ws, size_t ws_size, hipStream_t stream) {
    static int grid = 0;
    if (grid == 0) {
        if (n_in != 17 || in_sizes[0] != M * DM || out_size != M * DM || ws_size < WS_END) { fprintf(stderr, "kernel_launch: shape/workspace mismatch (n_in %d, in0 %d, out %d, ws %zu, need %zu)\n", n_in, n_in > 0 ? in_sizes[0] : -1, out_size, ws_size, (size_t)WS_END); grid = -1; return; }
        int dev = 0, cus = 0, per_cu = 0;
        if (hipGetDevice(&dev) != hipSuccess || hipDeviceGetAttribute(&cus, hipDeviceAttributeMultiprocessorCount, dev) != hipSuccess) { grid = -1; return; }
        if (hipFuncSetAttribute((const void*)mega_fwd, hipFuncAttributeMaxDynamicSharedMemorySize, LDS_BYTES) != hipSuccess) { fprintf(stderr, "kernel_launch: hipFuncSetAttribute failed\n"); grid = -1; return; }
        if (hipOccupancyMaxActiveBlocksPerMultiprocessor(&per_cu, (const void*)mega_fwd, NWAVES * 64, LDS_BYTES) != hipSuccess || per_cu < 1)
            fprintf(stderr, "kernel_launch: note: occupancy query reports %d workgroups per CU\n", per_cu);
        (void)hipGetLastError();
        grid = cus;
    }
    if (grid < 0) return;
    if (hipMemsetAsync((char*)d_ws + WS_CTL, 0, CTL_ZERO_BYTES, stream) != hipSuccess) return;
    Args a{};
    for (int i = 0; i < 17; ++i) a.in[i] = (const float*)d_in[i];
    a.out = (float*)d_out; a.ws = (unsigned char*)d_ws;
#if MK_PER_PHASE
    for (int p = 0; p < N_PHASES; ++p) { a.ph_lo = p; a.ph_hi = p + 1; hipLaunchKernelGGL(mega_fwd, dim3(grid), dim3(NWAVES * 64), LDS_BYTES, stream, a); }
#else
    a.ph_lo = 0; a.ph_hi = N_PHASES;
    hipLaunchKernelGGL(mega_fwd, dim3(grid), dim3(NWAVES * 64), LDS_BYTES, stream, a);
#endif
    const hipError_t le = hipPeekAtLastError();
    if (le != hipSuccess) fprintf(stderr, "kernel_launch: launch failed: %s\n", hipGetErrorName(le));
}
```

```cpp
#include <hip/hip_runtime.h>
#include <hip/hip_bf16.h>
#include <cstdio>
#include <cstdint>

#ifndef PROBE_DUP
#define PROBE_DUP -1
#endif
#define DUP(k) (PROBE_DUP == (k) ? 2 : 1)
#ifndef MK_PER_PHASE
#define MK_PER_PHASE 0
#endif

namespace pg8 {
#define PG8_LAS __attribute__((address_space(3)))
typedef unsigned short bf16_t;
typedef short bf16x8 __attribute__((ext_vector_type(8)));
typedef float f32x4 __attribute__((ext_vector_type(4)));
typedef float f32x2 __attribute__((ext_vector_type(2)));
typedef unsigned u32x4 __attribute__((ext_vector_type(4)));
constexpr int BM = 256, BK = 64, HALF = 128, HTB = HALF * BK * 2, STAGE_BYTES = 8 * HTB, NXCD = 8, WGM = 8;

__host__ __device__ __forceinline__ int lds_byte(int r, int c) { const int st = (r >> 4) * 2 + (c >> 5), rr = r & 15, cc = c & 31, ob = rr * 64 + cc * 2; return st * 1024 + (ob ^ (((ob >> 9) & 1) << 5)); }
__host__ __device__ __forceinline__ void stage_rc(int b, int& R, int& C) { const int st = b / 1024, sb = b % 1024, swz = sb ^ (((sb >> 9) & 1) << 5); R = (st >> 1) * 16 + swz / 64; C = (st & 1) * 32 + (swz % 64) / 2; }
__host__ __device__ __forceinline__ int perm32(int rho) { const int n = rho >> 4, i = rho & 15; return 8 * (i >> 2) + 4 * n + (i & 3); }

__device__ __forceinline__ int lane_id() { int r; asm volatile("v_mbcnt_lo_u32_b32 %0, -1, 0\n\tv_mbcnt_hi_u32_b32 %0, -1, %0" : "=v"(r)); return r; }
struct Unit { int pm, pn; };
struct Gemm { const bf16_t* A; const bf16_t* Bt; int M, N, K, lda, ldb; };

struct StaticOrder {
    int nM, nN, nwg, G, c, wgm;
    __host__ __device__ void init(int M, int N, int G_, int c_, int wgm_ = WGM) { nM = M / BM; nN = N / BM; nwg = nM * nN; G = G_; c = c_; wgm = wgm_; }
    __host__ __device__ bool next(int i, Unit& u) const {
        const long L = (long)i * G + c; if (L >= nwg) return false;
        int wgid = (int)L; { const int q = nwg / NXCD, r = nwg % NXCD, xcd = wgid % NXCD, off = wgid / NXCD; wgid = (xcd < r ? xcd * (q + 1) : r * (q + 1) + (xcd - r) * q) + off; }
        const int nig = wgm * nN, gid = wgid / nig, fm = gid * wgm, gsz = (nM - fm) < wgm ? (nM - fm) : wgm;
        u.pm = fm + ((wgid % nig) % gsz); u.pn = (wgid % nig) / gsz; return true;
    }
    __device__ __forceinline__ void a_ready(const Unit&) const {}
    __device__ __forceinline__ void done(const Unit&) const {}
};

__device__ __forceinline__ unsigned cvt_pk_bf16(float lo, float hi) { unsigned r; asm volatile("v_cvt_pk_bf16_f32 %0, %1, %2" : "=v"(r) : "v"(lo), "v"(hi)); return r; }
__device__ __forceinline__ unsigned pk4_fp8(float a, float b, float c, float d) { int w = __builtin_amdgcn_cvt_pk_fp8_f32(a, b, 0, false); w = __builtin_amdgcn_cvt_pk_fp8_f32(c, d, w, true); return (unsigned)w; }
typedef unsigned u32x2 __attribute__((ext_vector_type(2)));
__device__ __forceinline__ float bf_lo(unsigned w) { return __uint_as_float(w << 16); }
__device__ __forceinline__ float bf_hi(unsigned w) { return __uint_as_float(w & 0xffff0000u); }
__device__ __forceinline__ float sigmoidf_fast(float v) { return __builtin_amdgcn_rcpf(1.0f + __expf(-v)); }

typedef f32x4 Acc[2][2][4][2];

__device__ __forceinline__ void store_tile_bf16(const Acc& acc, bf16_t* base, int ldc, int row0, int col0, float sc = 1.0f) {
#pragma unroll
    for (int ai = 0; ai < 2; ++ai)
#pragma unroll
        for (int m = 0; m < 4; ++m) { bf16_t* rowp = base + (size_t)(row0 + ai * HALF + m * 16) * ldc + col0;
#pragma unroll
            for (int bj = 0; bj < 2; ++bj) { const f32x4 v0 = acc[ai][bj][m][0] * sc, v1 = acc[ai][bj][m][1] * sc;
                u32x4 w; w.x = cvt_pk_bf16(v0[0], v0[1]); w.y = cvt_pk_bf16(v0[2], v0[3]); w.z = cvt_pk_bf16(v1[0], v1[1]); w.w = cvt_pk_bf16(v1[2], v1[3]);
                *(u32x4*)(rowp + bj * HALF) = w; } }
}

struct EpiZ {
    static constexpr bool PERM = true, HAS_MID = false; static constexpr int NST = 16;
    bf16_t *zc, *zs, *zg, *zr;
    __device__ __forceinline__ void operator()(const Acc& acc, const Unit& u, int wr, int wc, int fr, int fq) const {
        const int pn = u.pn; bf16_t* base; int ldc, colt;
        if (pn < 24) { base = zc; ldc = 6144; colt = pn * 256; }
        else if (pn < 30) { base = zs; ldc = 1536; colt = (pn - 24) * 256; }
        else { base = zr; ldc = 256; colt = 0; }
        store_tile_bf16(acc, base, ldc, u.pm * BM + wr * 64 + fr, colt + wc * 32 + 8 * fq);
    }
};
struct EpiG8 {
    static constexpr bool PERM = true, HAS_MID = false; static constexpr int NST = 16;
    unsigned char* zg; float sc;
    __device__ __forceinline__ void operator()(const Acc& acc, const Unit& u, int wr, int wc, int, int) const {
        int lane_ = lane_id(); asm volatile("" : "+v"(lane_));
        const int fr = lane_ & 15, fq = lane_ >> 4;
        unsigned char* zb = zg + (size_t)(u.pm * BM + wr * 64 + fr) * 8192 + u.pn * 256 + wc * 32 + 8 * fq;
#pragma unroll
        for (int ai = 0; ai < 2; ++ai)
#pragma unroll
            for (int m = 0; m < 4; ++m)
#pragma unroll
                for (int bj = 0; bj < 2; ++bj) { const f32x4 v0 = acc[ai][bj][m][0] * sc, v1 = acc[ai][bj][m][1] * sc;
                    u32x2 w; w.x = pk4_fp8(v0[0], v0[1], v0[2], v0[3]); w.y = pk4_fp8(v1[0], v1[1], v1[2], v1[3]);
                    *(u32x2*)(zb + (size_t)(ai * HALF + m * 16) * 8192 + bj * HALF) = w; }
    }
};
struct EpiZ8 {
    static constexpr bool PERM = true, HAS_MID = false; static constexpr int NST = 16;
    bf16_t *zg, *zs, *zr; float sc;
    __device__ __forceinline__ void operator()(const Acc& acc, const Unit& u, int wr, int wc, int, int) const {
        int lane_ = lane_id(); asm volatile("" : "+v"(lane_));
        const int fr = lane_ & 15, fq = lane_ >> 4;
        const int pn = u.pn; bf16_t* base; int ldc, colt;
        if (pn < 6) { base = zs; ldc = 1536; colt = pn * 256; }
        else { base = zr; ldc = 256; colt = 0; }
        store_tile_bf16(acc, base, ldc, u.pm * BM + wr * 64 + fr, colt + wc * 32 + 8 * fq, sc);
    }
};
struct EpiBf16 {
    static constexpr bool PERM = true, HAS_MID = false; static constexpr int NST = 16;
    bf16_t* O; int ldc; float sc;
    __device__ __forceinline__ void operator()(const Acc& acc, const Unit& u, int wr, int wc, int fr, int fq) const {
        store_tile_bf16(acc, O, ldc, u.pm * BM + wr * 64 + fr, u.pn * BM + wc * 32 + 8 * fq, sc);
    }
};
struct EpiQ {
    static constexpr bool PERM = true, HAS_MID = false; static constexpr int NST = 16;
    unsigned char* Q8; const float* cs; float sc;
    __device__ __forceinline__ void operator()(const Acc& acc, const Unit& u, int wr, int wc, int fr, int fq) const {
        const int row0 = u.pm * BM + wr * 64 + fr;
        if (u.pn < 8) {
#pragma unroll
            for (int ai = 0; ai < 2; ++ai)
#pragma unroll
                for (int m = 0; m < 4; ++m) { unsigned char* rowp = Q8 + (size_t)(row0 + ai * HALF + m * 16) * 3072 + wc * 32 + 8 * fq;
#pragma unroll
                    for (int bj = 0; bj < 2; ++bj) { const f32x4 v0 = acc[ai][bj][m][0] * sc, v1 = acc[ai][bj][m][1] * sc;
                        u32x2 w; w.x = pk4_fp8(v0[0], v0[1], v0[2], v0[3]); w.y = pk4_fp8(v1[0], v1[1], v1[2], v1[3]);
                        *(u32x2*)(rowp + (2 * u.pn + bj) * 192) = w; } }
            return; }
        const int head = 4 * (u.pn - 8) + wc, i0 = 8 * fq;
#pragma unroll
        for (int ai = 0; ai < 2; ++ai)
#pragma unroll
            for (int m = 0; m < 4; ++m) { const int row = row0 + ai * HALF + m * 16;
                const f32x4* cp = (const f32x4*)(cs + (size_t)row * 64 + i0 * 2);
                const f32x4 c01 = cp[0], c23 = cp[1], c45 = cp[2], c67 = cp[3];
                const f32x4 a0 = acc[ai][0][m][0] * sc, a1 = acc[ai][0][m][1] * sc, b0 = acc[ai][1][m][0] * sc, b1 = acc[ai][1][m][1] * sc;
                float o1[8], o2[8];
                o1[0] = a0[0] * c01[0] - b0[0] * c01[1]; o2[0] = a0[0] * c01[1] + b0[0] * c01[0];
                o1[1] = a0[1] * c01[2] - b0[1] * c01[3]; o2[1] = a0[1] * c01[3] + b0[1] * c01[2];
                o1[2] = a0[2] * c23[0] - b0[2] * c23[1]; o2[2] = a0[2] * c23[1] + b0[2] * c23[0];
                o1[3] = a0[3] * c23[2] - b0[3] * c23[3]; o2[3] = a0[3] * c23[3] + b0[3] * c23[2];
                o1[4] = a1[0] * c45[0] - b1[0] * c45[1]; o2[4] = a1[0] * c45[1] + b1[0] * c45[0];
                o1[5] = a1[1] * c45[2] - b1[1] * c45[3]; o2[5] = a1[1] * c45[3] + b1[1] * c45[2];
                o1[6] = a1[2] * c67[0] - b1[2] * c67[1]; o2[6] = a1[2] * c67[1] + b1[2] * c67[0];
                o1[7] = a1[3] * c67[2] - b1[3] * c67[3]; o2[7] = a1[3] * c67[3] + b1[3] * c67[2];
                u32x2 w1, w2;
                w1.x = pk4_fp8(o1[0], o1[1], o1[2], o1[3]); w1.y = pk4_fp8(o1[4], o1[5], o1[6], o1[7]);
                w2.x = pk4_fp8(o2[0], o2[1], o2[2], o2[3]); w2.y = pk4_fp8(o2[4], o2[5], o2[6], o2[7]);
                unsigned char* rowp = Q8 + (size_t)row * 3072 + head * 192 + 128 + i0;
                *(u32x2*)rowp = w1; *(u32x2*)(rowp + 32) = w2; }
    }
};
struct EpiKV {
    static constexpr bool PERM = true, HAS_MID = false; static constexpr int NST = 16;
    unsigned char* K8n; unsigned char* V8T; float sc;
    __device__ __forceinline__ void operator()(const Acc& acc, const Unit& u, int wr, int wc, int fr, int fq) const {
        const int row0 = u.pm * BM + wr * 64 + fr, c0 = wc * 32 + 8 * fq;
        const int q = fr & 3; const unsigned sel = (unsigned)q | ((unsigned)(4 + q) << 8) | 0x0c0c0000u;
        unsigned char* vt = V8T + ((size_t)(((u.pm >> 4) * 16 + u.pn) * 64 + (u.pm & 15) * 4 + wr) * 128 + c0 + q) * 64 + 32 * ((fr >> 2) & 1) + 4 * (fr >> 3);
#pragma unroll
        for (int ai = 0; ai < 2; ++ai)
#pragma unroll
            for (int m = 0; m < 4; ++m) { const size_t row = (size_t)(row0 + ai * HALF + m * 16);
                { const f32x4 v0 = acc[ai][0][m][0] * sc, v1 = acc[ai][0][m][1] * sc; u32x2 w; w.x = pk4_fp8(v0[0], v0[1], v0[2], v0[3]); w.y = pk4_fp8(v1[0], v1[1], v1[2], v1[3]);
                  *(u32x2*)(K8n + row * 2048 + u.pn * 128 + c0) = w; }
#pragma unroll
                for (int n = 0; n < 2; ++n) { const f32x4 v = acc[ai][1][m][n] * sc; const int W = (int)pk4_fp8(v[0], v[1], v[2], v[3]);
                    const unsigned x0 = (unsigned)__builtin_amdgcn_update_dpp(0, W, 0x00, 0xF, 0xF, true), x1 = (unsigned)__builtin_amdgcn_update_dpp(0, W, 0x55, 0xF, 0xF, true);
                    const unsigned x2 = (unsigned)__builtin_amdgcn_update_dpp(0, W, 0xAA, 0xF, 0xF, true), x3 = (unsigned)__builtin_amdgcn_update_dpp(0, W, 0xFF, 0xF, 0xF, true);
                    const unsigned t01 = __builtin_amdgcn_perm(x1, x0, sel), t23 = __builtin_amdgcn_perm(x3, x2, sel);
                    *(unsigned*)(vt + (size_t)(ai * 2) * (128 * 64) + (4 * n) * 64 + 8 * m) = __builtin_amdgcn_perm(t23, t01, 0x05040100u); } }
    }
};
struct EpiGate {
    static constexpr bool PERM = true, HAS_MID = true; static constexpr int NST = 8;
    static constexpr int KSW = 32;
    static constexpr float SB = 2048.0f;
    const unsigned char* zg; const float* bg; bf16_t* O;
#define F8(w, i) __builtin_amdgcn_cvt_f32_fp8((int)(w), i)
    __device__ __forceinline__ static float pre(float z, float b) { return fminf(fmaxf(z + b, -40.f), 40.f); }
    __device__ __forceinline__ static float ratio(float za, float ba, float zb, float bb) { return SB * (1.0f + __expf(-pre(zb, bb))) * __builtin_amdgcn_rcpf(1.0f + __expf(-pre(za, ba))); }
    __device__ __forceinline__ static float sg(float z, float b) { return (1.0f / SB) * __builtin_amdgcn_rcpf(1.0f + __expf(-pre(z, b))); }
    __device__ __forceinline__ void mid(Acc& acc, const Unit& u, int wr_, int wc_, int, int) const {
        int tz = (wr_ * 4 + wc_) * 64 + lane_id(); asm volatile("" : "+v"(tz));
        const int wid_ = tz >> 6, lane_ = tz & 63, wr = wid_ >> 2, wc = wid_ & 3, fr = lane_ & 15, fq = lane_ >> 4;
        const int row0 = u.pm * BM + wr * 64 + fr, col0 = u.pn * BM + wc * 32 + 8 * fq;
#pragma unroll
        for (int bj = 0; bj < 2; ++bj) { const int col = col0 + bj * HALF;
            const f32x4 bA0 = *(const f32x4*)(bg + col), bA1 = *(const f32x4*)(bg + col + 4), bB0 = *(const f32x4*)(bg + 4096 + col), bB1 = *(const f32x4*)(bg + 4096 + col + 4);
#pragma unroll
            for (int ai = 0; ai < 2; ++ai) { u32x2 ga[4], gb[4];
#pragma unroll
                for (int m = 0; m < 4; ++m) { const unsigned char* rp = zg + (size_t)(row0 + ai * HALF + m * 16) * 8192 + col; ga[m] = *(const u32x2*)rp; gb[m] = *(const u32x2*)(rp + 4096); }
                asm volatile("s_waitcnt vmcnt(0)" ::: "memory");
#pragma unroll
                for (int m = 0; m < 4; ++m) { const u32x2 a = ga[m], b = gb[m]; f32x4 r0, r1;
                    r0[0] = ratio(F8(a.x, 0), bA0[0], F8(b.x, 0), bB0[0]); r0[1] = ratio(F8(a.x, 1), bA0[1], F8(b.x, 1), bB0[1]);
                    r0[2] = ratio(F8(a.x, 2), bA0[2], F8(b.x, 2), bB0[2]); r0[3] = ratio(F8(a.x, 3), bA0[3], F8(b.x, 3), bB0[3]);
                    r1[0] = ratio(F8(a.y, 0), bA1[0], F8(b.y, 0), bB1[0]); r1[1] = ratio(F8(a.y, 1), bA1[1], F8(b.y, 1), bB1[1]);
                    r1[2] = ratio(F8(a.y, 2), bA1[2], F8(b.y, 2), bB1[2]); r1[3] = ratio(F8(a.y, 3), bA1[3], F8(b.y, 3), bB1[3]);
                    acc[ai][bj][m][0] *= r0; acc[ai][bj][m][1] *= r1; }
                asm volatile("" ::: "memory"); }
            asm volatile("" ::: "memory"); }
    }
    __device__ __forceinline__ void operator()(const Acc& acc, const Unit& u, int wr, int wc, int fr, int fq) const {
        const int row0 = u.pm * BM + wr * 64 + fr, col0 = u.pn * BM + wc * 32 + 8 * fq;
#pragma unroll
        for (int bj = 0; bj < 2; ++bj) { const int col = col0 + bj * HALF;
            u32x2 gb[2][4];
#pragma unroll
            for (int ai = 0; ai < 2; ++ai)
#pragma unroll
                for (int m = 0; m < 4; ++m) gb[ai][m] = *(const u32x2*)(zg + (size_t)(row0 + ai * HALF + m * 16) * 8192 + 4096 + col);
            const f32x4 bB0 = *(const f32x4*)(bg + 4096 + col), bB1 = *(const f32x4*)(bg + 4096 + col + 4);
            asm volatile("s_waitcnt vmcnt(0)" ::: "memory");
#pragma unroll
            for (int ai = 0; ai < 2; ++ai)
#pragma unroll
                for (int m = 0; m < 4; ++m) { const size_t row = (size_t)(row0 + ai * HALF + m * 16); const u32x2 b = gb[ai][m];
                    const f32x4 v0 = acc[ai][bj][m][0], v1 = acc[ai][bj][m][1];
                    u32x4 w;
                    w.x = cvt_pk_bf16(v0[0] * sg(F8(b.x, 0), bB0[0]), v0[1] * sg(F8(b.x, 1), bB0[1]));
                    w.y = cvt_pk_bf16(v0[2] * sg(F8(b.x, 2), bB0[2]), v0[3] * sg(F8(b.x, 3), bB0[3]));
                    w.z = cvt_pk_bf16(v1[0] * sg(F8(b.y, 0), bB1[0]), v1[1] * sg(F8(b.y, 1), bB1[1]));
                    w.w = cvt_pk_bf16(v1[2] * sg(F8(b.y, 2), bB1[2]), v1[3] * sg(F8(b.y, 3), bB1[3]));
                    *(u32x4*)(O + row * 4096 + col) = w; } }
    }
};
struct EpiResF32 {
    static constexpr bool PERM = false, HAS_MID = false; static constexpr int NST = 8;
    const float* base; float* out; int ldc;
    __device__ __forceinline__ void operator()(const Acc& acc, const Unit& u, int wr, int wc, int fr, int fq) const {
        const int row0 = u.pm * BM + wr * 64 + fr, col0 = u.pn * BM + wc * 32 + 4 * fq;
#pragma unroll
        for (int ai = 0; ai < 2; ++ai) { f32x4 b[4][2][2];
#pragma unroll
            for (int m = 0; m < 4; ++m) { const size_t off = (size_t)(row0 + ai * HALF + m * 16) * ldc + col0;
#pragma unroll
                for (int bj = 0; bj < 2; ++bj)
#pragma unroll
                    for (int n = 0; n < 2; ++n) b[m][bj][n] = *(const f32x4*)(base + off + bj * HALF + n * 16); }
            asm volatile("" ::: "memory");
#pragma unroll
            for (int m = 0; m < 4; ++m) { const size_t off = (size_t)(row0 + ai * HALF + m * 16) * ldc + col0;
#pragma unroll
                for (int bj = 0; bj < 2; ++bj)
#pragma unroll
                    for (int n = 0; n < 2; ++n) *(f32x4*)(out + off + bj * HALF + n * 16) = b[m][bj][n] + acc[ai][bj][m][n]; }
            asm volatile("" ::: "memory"); }
    }
};
struct EpiRes1 {
    static constexpr bool PERM = true, HAS_MID = false; static constexpr int NST = 8;
    const float* base; bf16_t* xb; float* slots; int ldc;
    __device__ __forceinline__ void operator()(const Acc& acc, const Unit& u, int wr, int wc, int fr, int fq) const {
        const int row0 = u.pm * BM + wr * 64 + fr, col0 = u.pn * BM + wc * 32 + 8 * fq;
#pragma unroll
        for (int ai = 0; ai < 2; ++ai) { f32x4 b[4][2][2];
#pragma unroll
            for (int m = 0; m < 4; ++m) { const size_t off = (size_t)(row0 + ai * HALF + m * 16) * ldc + col0;
#pragma unroll
                for (int bj = 0; bj < 2; ++bj)
#pragma unroll
                    for (int n = 0; n < 2; ++n) b[m][bj][n] = *(const f32x4*)(base + off + bj * HALF + n * 4); }
            asm volatile("" ::: "memory");
#pragma unroll
            for (int m = 0; m < 4; ++m) { const int row = row0 + ai * HALF + m * 16; const size_t off = (size_t)row * ldc + col0; float ss = 0.f;
#pragma unroll
                for (int bj = 0; bj < 2; ++bj) { const f32x4 v0 = b[m][bj][0] + acc[ai][bj][m][0], v1 = b[m][bj][1] + acc[ai][bj][m][1];
                    ss += ((v0[0] * v0[0] + v0[1] * v0[1]) + (v0[2] * v0[2] + v0[3] * v0[3])) + ((v1[0] * v1[0] + v1[1] * v1[1]) + (v1[2] * v1[2] + v1[3] * v1[3]));
                    u32x4 w; w.x = cvt_pk_bf16(v0[0], v0[1]); w.y = cvt_pk_bf16(v0[2], v0[3]); w.z = cvt_pk_bf16(v1[0], v1[1]); w.w = cvt_pk_bf16(v1[2], v1[3]);
                    *(u32x4*)(xb + off + bj * HALF) = w; }
                ss += __shfl_xor(ss, 16); ss += __shfl_xor(ss, 32);
                if (fq == 0) slots[(size_t)row * 64 + 4 * u.pn + wc] = ss; }
            asm volatile("" ::: "memory"); }
    }
};
struct EpiResB {
    static constexpr bool PERM = true, HAS_MID = false; static constexpr int NST = 16;
    bf16_t* xb; int ldc;
    __device__ __forceinline__ void operator()(const Acc& acc, const Unit& u, int wr, int wc, int fr, int fq) const {
        const int row0 = u.pm * BM + wr * 64 + fr, col0 = u.pn * BM + wc * 32 + 8 * fq;
        u32x4 b[2][4][2];
#pragma unroll
        for (int ai = 0; ai < 2; ++ai)
#pragma unroll
            for (int m = 0; m < 4; ++m)
#pragma unroll
                for (int bj = 0; bj < 2; ++bj) b[ai][m][bj] = *(const u32x4*)(xb + (size_t)(row0 + ai * HALF + m * 16) * ldc + col0 + bj * HALF);
        asm volatile("" ::: "memory");
#pragma unroll
        for (int ai = 0; ai < 2; ++ai)
#pragma unroll
            for (int m = 0; m < 4; ++m)
#pragma unroll
                for (int bj = 0; bj < 2; ++bj) { const u32x4 x = b[ai][m][bj]; const f32x4 v0 = acc[ai][bj][m][0], v1 = acc[ai][bj][m][1];
                    u32x4 w; w.x = cvt_pk_bf16(bf_lo(x.x) + v0[0], bf_hi(x.x) + v0[1]); w.y = cvt_pk_bf16(bf_lo(x.y) + v0[2], bf_hi(x.y) + v0[3]);
                    w.z = cvt_pk_bf16(bf_lo(x.z) + v1[0], bf_hi(x.z) + v1[1]); w.w = cvt_pk_bf16(bf_lo(x.w) + v1[2], bf_hi(x.w) + v1[3]);
                    *(u32x4*)(xb + (size_t)(row0 + ai * HALF + m * 16) * ldc + col0 + bj * HALF) = w; }
    }
};
struct EpiSwiGLU {
    static constexpr bool PERM = true, HAS_MID = false; static constexpr int NST = 8;
    bf16_t* O; int ldc; const float* inv;
    __device__ __forceinline__ static float sw(float g, float u) { return g * __builtin_amdgcn_rcpf(1.0f + __expf(-g)) * u; }
    __device__ __forceinline__ void operator()(const Acc& acc, const Unit& u, int wr, int wc, int fr, int fq) const {
        const int row0 = u.pm * BM + wr * 64 + fr, col0 = u.pn * HALF + wc * 32 + 8 * fq;
        float ivs[2][4];
#pragma unroll
        for (int ai = 0; ai < 2; ++ai)
#pragma unroll
            for (int m = 0; m < 4; ++m) ivs[ai][m] = inv[row0 + ai * HALF + m * 16];
        asm volatile("s_waitcnt vmcnt(0)" ::: "memory");
#pragma unroll
        for (int ai = 0; ai < 2; ++ai)
#pragma unroll
            for (int m = 0; m < 4; ++m) { const float iv = ivs[ai][m];
                const f32x4 g0 = acc[ai][0][m][0] * iv, g1 = acc[ai][0][m][1] * iv, u0 = acc[ai][1][m][0] * iv, u1 = acc[ai][1][m][1] * iv;
                u32x4 w;
                w.x = cvt_pk_bf16(sw(g0[0], u0[0]), sw(g0[1], u0[1])); w.y = cvt_pk_bf16(sw(g0[2], u0[2]), sw(g0[3], u0[3]));
                w.z = cvt_pk_bf16(sw(g1[0], u1[0]), sw(g1[1], u1[1])); w.w = cvt_pk_bf16(sw(g1[2], u1[2]), sw(g1[3], u1[3]));
                *(u32x4*)(O + (size_t)(row0 + ai * HALF + m * 16) * ldc + col0) = w; }
    }
};

template <class Epi, class Sched, bool ALIGN_EPI = false, bool SP2 = false, bool RELAX = true, bool FP8 = false, bool MIXED = false, bool SC = false>
__device__ __forceinline__ void gemm_phase(PG8_LAS unsigned char* lds, const Gemm g, const Sched& S, const Epi& E, const int wv) {
    int tid_ = wv * 64 + lane_id(); asm volatile("" : "+v"(tid_));
    const int tid = tid_, wid = __builtin_amdgcn_readfirstlane(tid >> 6), lane = tid & 63, wr = wid >> 2, wc = wid & 3, fr = lane & 15, fq = lane >> 4;
    const int K = g.K, nt = K / BK; int tmid = nt / 2; if constexpr (MIXED) tmid = Epi::KSW;
    unsigned voffA, voffB;
    { int R, C; stage_rc(tid * 16, R, C); const int Rb = Epi::PERM ? ((R & ~31) + perm32(R & 31)) : R;
      voffA = (unsigned)(R * g.lda + C) * 2u; voffB = (unsigned)(Rb * g.ldb + C) * 2u; }
    const size_t d64A = (size_t)64 * g.lda * 2, d64B = (size_t)64 * g.ldb * 2;
    const size_t kstep = (size_t)(BK * 2);
    const size_t hsA = (size_t)HALF * g.lda * 2, hsB = (size_t)HALF * g.ldb * 2;
    const size_t tsA = 2 * hsA, tsB = 2 * hsB;
    const unsigned ldsw = (unsigned)wid * 1024u;
    const int aoff = lds_byte(wr * 64 + fr, fq * 8);
    const int dAB = __builtin_amdgcn_readfirstlane((wc * 4 - wr * 8) * 1024);
#define PG8_SA(b, h) (((b) * 2 + (h)) * HTB)
#define PG8_SB(b, h) ((4 + (b) * 2 + (h)) * HTB)
#define PG8_STAGE(bufoff, gbase, X) do { _Pragma("unroll") for (int _i = 0; _i < 2; ++_i) \
        __builtin_amdgcn_global_load_lds((const unsigned*)((const char*)(gbase) + _i * d64##X + voff##X), (PG8_LAS unsigned*)(lds + (bufoff) + ldsw + _i * 8192), 16, 0, 0); } while (0)
#define PG8_LDA(dst, b, h) do { _Pragma("unroll") for (int m = 0; m < 4; ++m) _Pragma("unroll") for (int k = 0; k < 2; ++k) dst[m][k] = *(const PG8_LAS bf16x8*)(lds + PG8_SA(b, h) + aoff + m * 2048 + k * 1024); } while (0)
#define PG8_LDB(dst, b, h) do { _Pragma("unroll") for (int n = 0; n < 2; ++n) _Pragma("unroll") for (int k = 0; k < 2; ++k) dst[n][k] = *(const PG8_LAS bf16x8*)(lds + PG8_SB(b, h) + dAB + aoff + n * 2048 + k * 1024); } while (0)
    typedef long l64x2 __attribute__((ext_vector_type(2)));
    typedef int i32x4 __attribute__((ext_vector_type(4))); typedef int i32x8 __attribute__((ext_vector_type(8)));
#define PG8_MMA(ai, bj, At, Bt, F8) do { __builtin_amdgcn_s_setprio(1); \
        if constexpr (!(F8)) { _Pragma("unroll") for (int k = 0; k < 2; ++k) _Pragma("unroll") for (int m = 0; m < 4; ++m) _Pragma("unroll") for (int n = 0; n < 2; ++n) \
            acc[ai][bj][m][n] = __builtin_amdgcn_mfma_f32_16x16x32_bf16(Bt[n][k], At[m][k], acc[ai][bj][m][n], 0, 0, 0); } \
        else if constexpr (!SC) { _Pragma("unroll") for (int k = 0; k < 2; ++k) _Pragma("unroll") for (int hh = 0; hh < 2; ++hh) _Pragma("unroll") for (int m = 0; m < 4; ++m) _Pragma("unroll") for (int n = 0; n < 2; ++n) \
            acc[ai][bj][m][n] = __builtin_amdgcn_mfma_f32_16x16x32_fp8_fp8(__builtin_bit_cast(l64x2, Bt[n][k])[hh], __builtin_bit_cast(l64x2, At[m][k])[hh], acc[ai][bj][m][n], 0, 0, 0); } \
        else { _Pragma("unroll") for (int m = 0; m < 4; ++m) _Pragma("unroll") for (int n = 0; n < 2; ++n) { \
            const i32x8 b8_ = __builtin_shufflevector(__builtin_bit_cast(i32x4, Bt[n][0]), __builtin_bit_cast(i32x4, Bt[n][1]), 0, 1, 2, 3, 4, 5, 6, 7); \
            const i32x8 a8_ = __builtin_shufflevector(__builtin_bit_cast(i32x4, At[m][0]), __builtin_bit_cast(i32x4, At[m][1]), 0, 1, 2, 3, 4, 5, 6, 7); \
            acc[ai][bj][m][n] = __builtin_amdgcn_mfma_scale_f32_16x16x128_f8f6f4(b8_, a8_, acc[ai][bj][m][n], 0, 0, 0, 0, 0, 0); } } \
        __builtin_amdgcn_s_setprio(0); } while (0)
#define PG8_WAIT_V(n) asm volatile("s_waitcnt vmcnt(" #n ")" ::: "memory")
#define PG8_WAIT_L(n) asm volatile("s_waitcnt lgkmcnt(" #n ")" ::: "memory")
#define PG8_BAR __builtin_amdgcn_s_barrier()
#define PG8_SCHED __builtin_amdgcn_sched_barrier(0)
    Unit cur, nxt; int ui = 0;
    if (!S.next(0, cur)) return;
    Acc acc;
#pragma unroll
    for (int a = 0; a < 2; ++a)
#pragma unroll
        for (int b = 0; b < 2; ++b)
#pragma unroll
            for (int m = 0; m < 4; ++m)
#pragma unroll
                for (int n = 0; n < 2; ++n) acc[a][b][m][n] = (f32x4){0.f, 0.f, 0.f, 0.f};
    bf16x8 At[4][2], B0[2][2], B1[2][2];
    const char* cA = (const char*)g.A + (size_t)cur.pm * tsA; const char* cB = (const char*)g.Bt + (size_t)cur.pn * tsB;
    S.a_ready(cur);
    if constexpr (SP2) {
        PG8_STAGE(PG8_SB(0, 0), cB, B); PG8_STAGE(PG8_SB(0, 1), cB + hsB, B); PG8_STAGE(PG8_SA(0, 0), cA, A); PG8_STAGE(PG8_SA(0, 1), cA + hsA, A);
        if (wr == 1) PG8_BAR;
        PG8_WAIT_V(2); PG8_BAR;
        PG8_STAGE(PG8_SB(1, 0), cB + kstep, B); PG8_STAGE(PG8_SA(1, 0), cA + kstep, A); PG8_STAGE(PG8_SB(1, 1), cB + hsB + kstep, B);
        PG8_WAIT_V(0); PG8_BAR;
    } else {
        PG8_STAGE(PG8_SB(0, 0), cB, B); PG8_STAGE(PG8_SA(0, 0), cA, A); PG8_STAGE(PG8_SB(0, 1), cB + hsB, B); PG8_STAGE(PG8_SA(0, 1), cA + hsA, A);
        if (wr == 1) PG8_BAR;
        PG8_WAIT_V(4); PG8_BAR;
        PG8_STAGE(PG8_SB(1, 0), cB + kstep, B); PG8_STAGE(PG8_SA(1, 0), cA + kstep, A); PG8_STAGE(PG8_SB(1, 1), cB + hsB + kstep, B);
        PG8_WAIT_V(6); PG8_BAR;
    }
    for (;;) {
        const bool has_next = S.next(ui + 1, nxt);
        const char* nA = has_next ? (const char*)g.A + (size_t)nxt.pm * tsA : cA; const char* nB = has_next ? (const char*)g.Bt + (size_t)nxt.pn * tsB : cB;
        static_assert(SP2, "only the two-blocks-per-barrier K-loop is kept");
#define PG8_TRIP(T, WV, F8) do { const int t = (T); const bool last = (t == nt - 2); \
            const char* a1 = cA + (size_t)(t + 1) * kstep; \
            const char* a2 = last ? nA : cA + (size_t)(t + 2) * kstep; const char* b2 = last ? nB : cB + (size_t)(t + 2) * kstep; \
            const char* a3 = a2 + kstep; const char* b3 = b2 + kstep; \
            if (last && has_next) S.a_ready(nxt); \
            if constexpr (Epi::HAS_MID && !MIXED) { if (t == tmid) E.mid(acc, cur, wr, wc, fr, fq); } \
            PG8_LDB(B0, 0, 0); PG8_LDB(B1, 0, 1); PG8_SCHED; PG8_LDA(At, 0, 0); PG8_STAGE(PG8_SA(1, 1), a1 + hsA, A); \
            asm volatile("s_waitcnt vmcnt(%0)" :: "n"(WV) : "memory"); PG8_WAIT_L(0); PG8_BAR; PG8_MMA(0, 0, At, B0, F8); PG8_MMA(0, 1, At, B1, F8); PG8_BAR; PG8_SCHED; \
            PG8_LDA(At, 0, 1); PG8_STAGE(PG8_SB(0, 0), b2, B); PG8_STAGE(PG8_SB(0, 1), b2 + hsB, B); PG8_STAGE(PG8_SA(0, 0), a2, A); \
            asm volatile("s_waitcnt vmcnt(%0)" :: "n"(WV) : "memory"); PG8_WAIT_L(0); PG8_BAR; PG8_MMA(1, 0, At, B0, F8); PG8_MMA(1, 1, At, B1, F8); PG8_BAR; PG8_SCHED; \
            PG8_LDB(B0, 1, 0); PG8_LDB(B1, 1, 1); PG8_SCHED; PG8_LDA(At, 1, 0); PG8_STAGE(PG8_SA(0, 1), a2 + hsA, A); \
            PG8_WAIT_V(8); PG8_WAIT_L(0); PG8_BAR; PG8_MMA(0, 0, At, B0, F8); PG8_MMA(0, 1, At, B1, F8); PG8_BAR; PG8_SCHED; \
            PG8_LDA(At, 1, 1); PG8_STAGE(PG8_SB(1, 0), b3, B); PG8_STAGE(PG8_SB(1, 1), b3 + hsB, B); PG8_STAGE(PG8_SA(1, 0), a3, A); \
            PG8_WAIT_V(8); PG8_WAIT_L(0); PG8_BAR; PG8_MMA(1, 0, At, B0, F8); PG8_MMA(1, 1, At, B1, F8); PG8_BAR; PG8_SCHED; } while (0)
        if constexpr (MIXED) { static_assert(!RELAX && !FP8, "mixed K-loop: plain waits");
_Pragma("unroll 1") for (int tt = 0; tt < Epi::KSW; tt += 2) PG8_TRIP(tt, 8, false);
            if constexpr (Epi::HAS_MID) E.mid(acc, cur, wr, wc, fr, fq);
_Pragma("unroll 1") for (int tt = Epi::KSW; tt < nt; tt += 2) PG8_TRIP(tt, 8, true); }
        else if constexpr (RELAX) { PG8_TRIP(0, 8 + Epi::NST, FP8); for (int tt = 2; tt < nt; tt += 2) PG8_TRIP(tt, 8, FP8); }
        else { for (int tt = 0; tt < nt; tt += 2) PG8_TRIP(tt, 8, FP8); }
#undef PG8_TRIP
        if constexpr (ALIGN_EPI) { if (wr == 0) PG8_BAR; }
        E(acc, cur, wr, wc, fr, fq); S.done(cur);
        if (!has_next) break;
#pragma unroll
        for (int a = 0; a < 2; ++a)
#pragma unroll
            for (int b = 0; b < 2; ++b)
#pragma unroll
                for (int m = 0; m < 4; ++m)
#pragma unroll
                    for (int n = 0; n < 2; ++n) acc[a][b][m][n] = (f32x4){0.f, 0.f, 0.f, 0.f};
        cur = nxt; cA = nA; cB = nB; ++ui;
        if constexpr (ALIGN_EPI) { if (wr == 1) PG8_BAR; }
    }
    PG8_WAIT_V(0);
    if constexpr (!ALIGN_EPI) { if (wr == 0) PG8_BAR; }
    PG8_BAR;
#undef PG8_SA
#undef PG8_SB
#undef PG8_STAGE
#undef PG8_LDA
#undef PG8_LDB
#undef PG8_MMA
#undef PG8_WAIT_V
#undef PG8_WAIT_L
#undef PG8_BAR
#undef PG8_SCHED
}
}

namespace mla {
using bf16x8 = __attribute__((ext_vector_type(8))) short;
using s16x4  = __attribute__((ext_vector_type(4))) short;
using f32x16 = __attribute__((ext_vector_type(16))) float;
using u32x4  = __attribute__((ext_vector_type(4))) unsigned;
typedef unsigned short bf16_t;
using u32x2 = __attribute__((ext_vector_type(2))) unsigned;
constexpr int NW = 8, QBLK = 32, KVBLK = 64;
constexpr float SCALE = 0.07216878364870323f;
constexpr float THR = 4.f;
constexpr float PLOG2 = 3.f;
constexpr int SDEPTH = 1;
constexpr int KROW = 200;
constexpr int VROW = 72;
constexpr int SHM_V = 128 * VROW, SHM_K = KVBLK * KROW, NVB = 3, SHM_ATTN = NVB * SHM_V + 2 * SHM_K + NW * 64 * 4;
static_assert(SHM_ATTN <= 131072, "attention LDS fits the ring region");
constexpr int LDQ8 = 3072, LDK8 = 2048, LDKR8 = 64, LDKV = 4096, LDO = 8192;
constexpr float OSC = 64.0f;
#define MLA_KSWZ(row, colB) ((row) * 384 + ((colB) ^ ((((row) >> 1) & 7) << 4)))
#define MLA_SBAR() __builtin_amdgcn_sched_barrier(0)
#define MLA_SBM() __builtin_amdgcn_sched_barrier(0x406)
__device__ __forceinline__ int crow(int r, int hi) { return (r & 3) + 8 * (r >> 2) + 4 * hi; }
__device__ __forceinline__ unsigned cvtpk(float lo, float hi) { unsigned r; asm volatile("v_cvt_pk_bf16_f32 %0, %1, %2" : "=v"(r) : "v"(lo), "v"(hi)); return r; }
__device__ __forceinline__ bf16x8 ld8(const bf16_t* p) { return *reinterpret_cast<const bf16x8*>(p); }

constexpr float THR_L2 = THR * 1.4426950408889634f;
template <bool FIRST> __device__ __forceinline__ void partialSM(f32x16& p0, f32x16& p1, f32x16& mneg, float& alpha) {
  float pmax = p0[0];
#pragma unroll
  for (int r = 1; r < 16; ++r) pmax = fmaxf(pmax, p0[r]);
#pragma unroll
  for (int r = 0; r < 16; ++r) pmax = fmaxf(pmax, p1[r]);
  { auto rr = __builtin_amdgcn_permlane32_swap(__float_as_uint(pmax), __float_as_uint(pmax), false, false);
    pmax = fmaxf(__uint_as_float(rr[0]), __uint_as_float(rr[1])); }
  float delta = pmax - PLOG2;
  if (!FIRST && __builtin_expect(__all(delta <= THR_L2), 1)) { alpha = 1.f; }
  else { if (!FIRST) delta = fmaxf(delta, 0.f);
    alpha = __builtin_amdgcn_exp2f(-delta);
#pragma unroll
    for (int r = 0; r < 16; ++r) { p0[r] -= delta; p1[r] -= delta; mneg[r] -= delta; } }
#pragma unroll
  for (int r = 0; r < 16; ++r) p0[r] = __builtin_amdgcn_exp2f(p0[r]);
}
__device__ __forceinline__ void finishSM(f32x16& p0, f32x16& p1, float alpha, float& l_reg, long& pa0, long& pa1, long& pa2, long& pa3) {
#pragma unroll
  for (int r = 0; r < 16; ++r) p1[r] = __builtin_amdgcn_exp2f(p1[r]);
  float ps = 0;
#pragma unroll
  for (int r = 0; r < 16; ++r) ps += p0[r];
#pragma unroll
  for (int r = 0; r < 16; ++r) ps += p1[r];
  { auto rr = __builtin_amdgcn_permlane32_swap(__float_as_uint(ps), __float_as_uint(ps), false, false);
    ps = __uint_as_float(rr[0]) + __uint_as_float(rr[1]); }
  l_reg = l_reg * alpha + ps;
#define MLA_PK8(P, BASE, OUT) do { const unsigned a_ = pg8::pk4_fp8(P[BASE + 0], P[BASE + 1], P[BASE + 2], P[BASE + 3]), b_ = pg8::pk4_fp8(P[BASE + 4], P[BASE + 5], P[BASE + 6], P[BASE + 7]); \
    OUT = (long)(((unsigned long long)b_ << 32) | (unsigned long long)a_); } while (0)
  MLA_PK8(p0, 0, pa0); MLA_PK8(p0, 8, pa1); MLA_PK8(p1, 0, pa2); MLA_PK8(p1, 8, pa3);
#undef MLA_PK8
}
#define MLA_LDV(addr) (*reinterpret_cast<const volatile __attribute__((address_space(3))) long*>((uintptr_t)(unsigned)(addr)))
typedef long l64x4 __attribute__((ext_vector_type(4))); typedef int i32x8 __attribute__((ext_vector_type(8)));
#define MLA_MMA64(a4, b4, c) __builtin_amdgcn_mfma_scale_f32_32x32x64_f8f6f4(__builtin_bit_cast(i32x8, a4), __builtin_bit_cast(i32x8, b4), c, 0, 0, 0, 0, 0, 0)
struct VFrag { l64x4 v; };
template <int D0> __device__ __forceinline__ void pv_read(VFrag& f, int vb) {
  f.v[0] = MLA_LDV(vb + D0 * 32 * VROW); f.v[1] = MLA_LDV(vb + D0 * 32 * VROW + 8); f.v[2] = MLA_LDV(vb + D0 * 32 * VROW + 16); f.v[3] = MLA_LDV(vb + D0 * 32 * VROW + 24);
}
#define MLA_KLD(T, s_, rb) do { T[0] = MLA_LDV(kb + BUFOFF + (rb) * 32 * KROW + (4 * (s_)) * 16); T[1] = MLA_LDV(kb + BUFOFF + (rb) * 32 * KROW + (4 * (s_) + 1) * 16); \
    T[2] = MLA_LDV(kb + BUFOFF + (rb) * 32 * KROW + (4 * (s_) + 2) * 16); T[3] = MLA_LDV(kb + BUFOFF + (rb) * 32 * KROW + (4 * (s_) + 3) * 16); } while (0)
template <int BUFOFF, bool PFV> __device__ __forceinline__ void qkt(f32x16& p0, f32x16& p1, const f32x16& mneg, int kb, const l64x4* qv, VFrag& fa, VFrag& fb, int vb) {
  l64x4 t0, t1, t2;
  MLA_KLD(t0, 0, 0); MLA_KLD(t1, 0, 1); MLA_KLD(t2, 1, 0);
  p0 = MLA_MMA64(t0, qv[0], mneg); MLA_SBM(); MLA_KLD(t0, 1, 1);
  p1 = MLA_MMA64(t1, qv[0], mneg); MLA_SBM(); MLA_KLD(t1, 2, 0);
  p0 = MLA_MMA64(t2, qv[1], p0); MLA_SBM(); MLA_KLD(t2, 2, 1);
  p1 = MLA_MMA64(t0, qv[1], p1); MLA_SBM(); if constexpr (PFV) pv_read<0>(fa, vb);
  p0 = MLA_MMA64(t1, qv[2], p0); MLA_SBM(); if constexpr (PFV) pv_read<1>(fb, vb);
  p1 = MLA_MMA64(t2, qv[2], p1); MLA_SBM();
}
#undef MLA_KLD
__device__ __forceinline__ void pv_mma(f32x16& od, const VFrag& f, long pa0, long pa1, long pa2, long pa3) {
  const l64x4 pa = {pa0, pa1, pa2, pa3};
  od = MLA_MMA64(pa, f.v, od);
}
__device__ __forceinline__ void pv_d0_pre(f32x16* o, int vb, long pa0, long pa1, long pa2, long pa3, VFrag& fa, VFrag& fb) {
  pv_mma(o[0], fa, pa0, pa1, pa2, pa3); MLA_SBM();
  pv_read<2>(fa, vb);
  pv_mma(o[1], fb, pa0, pa1, pa2, pa3); MLA_SBM();
  pv_read<3>(fb, vb);
  pv_mma(o[2], fa, pa0, pa1, pa2, pa3); MLA_SBM();
  pv_mma(o[3], fb, pa0, pa1, pa2, pa3);
}
__device__ __forceinline__ void pv_d0(f32x16* o, int vb, long pa0, long pa1, long pa2, long pa3) {
  VFrag fa, fb;
  pv_read<0>(fa, vb); pv_read<1>(fb, vb);
  pv_d0_pre(o, vb, pa0, pa1, pa2, pa3, fa, fb);
}
#define MLA_PIN2(a, b) asm volatile("" : "+v"(a), "+v"(b))

__device__ __forceinline__ void attn_unit(const unsigned char* __restrict__ Q8, const unsigned char* __restrict__ K8, const unsigned char* __restrict__ Kr8,
                                          const unsigned char* __restrict__ Vh, unsigned char* __restrict__ Ob, int seq, char* lds, const int wv) {
  const int tid = wv * 64 + pg8::lane_id(), wid = tid >> 6, lane = tid & 63, r32 = lane & 31, hi = lane >> 5;
  char* V_lds = lds; char* K_lds = lds + NVB * SHM_V;
  float* ws = (float*)(lds + NVB * SHM_V + 2 * SHM_K) + wid * 64; float* li_l = ws; float* al_l = ws + 32;
  float l_reg = 0; f32x16 o[4] = {}; l64x4 qv[3]; f32x16 mneg;
#pragma unroll
  for (int r = 0; r < 16; ++r) mneg[r] = PLOG2;
  { int tq = wv * 64 + pg8::lane_id(); asm volatile("" : "+v"(tq));
    const unsigned qoff = (unsigned)((tq >> 6) * QBLK + (tq & 31)) * (unsigned)LDQ8 + (unsigned)(((tq >> 5) & 1) * 8);
    const unsigned char* qp = Q8 + qoff;
#pragma unroll
    for (int d0 = 0; d0 < 12; ++d0) qv[d0 >> 2][d0 & 3] = *(const long*)(qp + d0 * 16); }
  const int vst = (tid >> 2) * VROW + (tid & 3) * 16;
  const int kr = tid >> 3, kc = tid & 7;
  const int kst = kr * KROW + kc * 16, rst = kr * KROW + 128 + kc * 8;
  const int vb0 = (int)(uintptr_t)V_lds + r32 * VROW + hi * 32;
  const int kb = (int)(uintptr_t)K_lds + r32 * KROW + hi * 8;
  struct { u32x4 vs; u32x4 kn; long krp; } sr_[SDEPTH];
  const unsigned offV = (unsigned)tid * 16u, offK = (unsigned)(kr * LDK8 + kc * 16), offR = (unsigned)(kr * LDKR8 + kc * 8);
#define MLA_SLOAD(i, k0) do { const unsigned char* vb_ = Vh + (size_t)(k0) * 128; const unsigned char* kb_ = K8 + (size_t)(k0) * LDK8; const unsigned char* rb_ = Kr8 + (size_t)(k0) * LDKR8; \
    sr_[i].vs = *(const u32x4*)(vb_ + offV); \
    sr_[i].kn = *(const u32x4*)(kb_ + offK); sr_[i].krp = *(const long*)(rb_ + offR); } while (0)
#define MLA_SWRITE(b, vo, i) do { *(u32x2*)(V_lds + (vo) + vst) = (u32x2){sr_[i].vs.x, sr_[i].vs.y}; *(u32x2*)(V_lds + (vo) + vst + 8) = (u32x2){sr_[i].vs.z, sr_[i].vs.w}; \
    *(u32x2*)(K_lds + (b) * SHM_K + kst) = (u32x2){sr_[i].kn.x, sr_[i].kn.y}; *(u32x2*)(K_lds + (b) * SHM_K + kst + 8) = (u32x2){sr_[i].kn.z, sr_[i].kn.w}; \
    *(long*)(K_lds + (b) * SHM_K + rst) = sr_[i].krp; } while (0)
#define MLA_SWAIT() do { if constexpr (SDEPTH == 2) asm volatile("s_waitcnt vmcnt(4)" ::: "memory"); else asm volatile("s_waitcnt vmcnt(0)" ::: "memory"); } while (0)
#define MLA_RESC(a) do { if (__any((a) < 1.f)) { if (hi == 0) al_l[r32] = (a); asm volatile("s_waitcnt lgkmcnt(0)" ::: "memory"); \
    _Pragma("unroll") for (int d = 0; d < 4; ++d) _Pragma("unroll") for (int r = 0; r < 16; ++r) o[d][r] *= al_l[crow(r, hi)]; } } while (0)
  f32x16 pA0, pA1, pB0, pB1; float alA, alB; long pa0, pa1, pa2, pa3; const int NT = seq / KVBLK;
  constexpr int SE = 0, SO = SDEPTH - 1;
  static_assert(SDEPTH == 1, "one tile of register staging");
#define MLA_VNEXT(v) ((v) + SHM_V == NVB * SHM_V ? 0 : (v) + SHM_V)
  MLA_SLOAD(SE, 0); asm volatile("s_waitcnt vmcnt(0)" ::: "memory"); MLA_SWRITE(0, 0, SE); __syncthreads();
  mla::VFrag fa, fb;
  qkt<0, false>(pA0, pA1, mneg, kb, qv, fa, fb, vb0); partialSM<true>(pA0, pA1, mneg, alA);
  MLA_SLOAD(SO, KVBLK);
  MLA_SWAIT(); MLA_SWRITE(1, SHM_V, SO); __syncthreads();
  int vo = 0;
  for (int j = 1; j + 1 < NT; j += 2) {
    { const int vw = MLA_VNEXT(MLA_VNEXT(vo));
      MLA_SBAR(); qkt<SHM_K, true>(pB0, pB1, mneg, kb, qv, fa, fb, vb0 + vo);
      finishSM(pA0, pA1, alA, l_reg, pa0, pa1, pa2, pa3); MLA_SBAR();
      MLA_SLOAD(SO, (j + 1) * KVBLK); MLA_SBAR();
      pv_d0_pre(o, vb0 + vo, pa0, pa1, pa2, pa3, fa, fb); partialSM<false>(pB0, pB1, mneg, alB); MLA_PIN2(pB0, pB1);
      MLA_SWAIT(); MLA_SWRITE(0, vw, SE);
      MLA_RESC(alB); __syncthreads(); vo = MLA_VNEXT(vo); }
    { const int vw = MLA_VNEXT(MLA_VNEXT(vo));
      MLA_SBAR(); qkt<0, true>(pA0, pA1, mneg, kb, qv, fa, fb, vb0 + vo);
      finishSM(pB0, pB1, alB, l_reg, pa0, pa1, pa2, pa3); MLA_SBAR();
      MLA_SLOAD(SE, (j + 2) * KVBLK); MLA_SBAR();
      pv_d0_pre(o, vb0 + vo, pa0, pa1, pa2, pa3, fa, fb); partialSM<false>(pA0, pA1, mneg, alA); MLA_PIN2(pA0, pA1);
      MLA_SWAIT(); MLA_SWRITE(1, vw, SO);
      MLA_RESC(alA); __syncthreads(); vo = MLA_VNEXT(vo); }
  }
  MLA_SBAR(); qkt<SHM_K, true>(pB0, pB1, mneg, kb, qv, fa, fb, vb0 + vo);
  finishSM(pA0, pA1, alA, l_reg, pa0, pa1, pa2, pa3); MLA_SBAR();
  pv_d0_pre(o, vb0 + vo, pa0, pa1, pa2, pa3, fa, fb); partialSM<false>(pB0, pB1, mneg, alB);
  MLA_RESC(alB);
  finishSM(pB0, pB1, alB, l_reg, pa0, pa1, pa2, pa3); MLA_SBAR();
  pv_d0(o, vb0 + MLA_VNEXT(vo), pa0, pa1, pa2, pa3);
#undef MLA_VNEXT
  if (hi == 0) li_l[r32] = l_reg; asm volatile("s_waitcnt lgkmcnt(0)" ::: "memory");
  { int tz = wv * 64 + pg8::lane_id(); asm volatile("" : "+v"(tz));
    const int lane2 = tz & 63, r32b = lane2 & 31, hib = lane2 >> 5, widb = tz >> 6;
    unsigned char* Ow = Ob + (long)(widb * QBLK) * LDO + r32b;
#pragma unroll
    for (int r = 0; r < 16; ++r) { const int orow = crow(r, hib); const float rl = OSC * __builtin_amdgcn_rcpf(li_l[orow]);
#pragma unroll
      for (int d0 = 0; d0 < 4; ++d0) Ow[(long)orow * LDO + d0 * 32] = (unsigned char)(__builtin_amdgcn_cvt_pk_fp8_f32(o[d0][r] * rl, 0.f, 0, false) & 0xff); } }
#undef MLA_SLOAD
#undef MLA_SWRITE
#undef MLA_SWAIT
#undef MLA_RESC
}
}

constexpr int NWAVES = 8;
constexpr int BATCH = 4, SEQ = 4096, DM = 4096, M = BATCH * SEQ;
constexpr int CONV = 2048, QL = 1024, KVL = 512, NH = 16, DFF = 11008;
constexpr int IN_COLS = 15936, NZ = 16128;
constexpr int NQ = 3072, NKV = 4096, NGU = 2 * DFF;
constexpr float RMS_EPS = 1e-6f;

constexpr size_t MiB = 1u << 20;
constexpr size_t WS_CTL = 0, CTL_ZERO_BYTES = 1 * MiB;
constexpr size_t WS_WIN = 1 * MiB;
constexpr size_t WS_WQB = WS_WIN + (size_t)NZ * DM * 2;
constexpr size_t WS_WKVB = WS_WQB + (size_t)NQ * QL * 2;
constexpr size_t WS_WBR = WS_WKVB + (size_t)NKV * KVL * 2;
constexpr size_t WS_WOUT = WS_WBR + (size_t)DM * DM * 2;
constexpr size_t WS_WGU = WS_WOUT + (size_t)DM * DM * 2;
constexpr size_t WS_WDN = WS_WGU + (size_t)NGU * DM * 2;
constexpr size_t WS_RA = WS_WDN + (size_t)DM * DFF * 2;
constexpr size_t WS_ZC = WS_RA + (size_t)M * DM * 2;
constexpr size_t WS_ZS = WS_ZC + (size_t)M * 6144 * 2;
constexpr size_t WS_ZR = WS_ZS + (size_t)M * 1536 * 2;
constexpr size_t WS_ZG = WS_ZR + (size_t)M * 256 * 2;
constexpr size_t WS_H8 = WS_ZG + (size_t)M * 8192 * 2;
constexpr size_t WS_END = WS_H8 + (size_t)M * DM;
constexpr size_t WS_WG8 = WS_WIN;
constexpr size_t WS_KV = WS_ZC, WS_H2 = WS_ZC, WS_ACT = WS_ZC + (size_t)M * DM * 2;
static_assert(WS_ACT + (size_t)M * DFF * 2 <= WS_END, "act overlay fits");
constexpr size_t WS_SLOTS = WS_WIN + 64 * MiB, WS_INV = WS_SLOTS + (size_t)16384 * 64 * 4;
constexpr size_t WS_QN = WS_WIN, WS_KVN = WS_QN + (size_t)M * QL * 2, WS_KR = WS_KVN + (size_t)M * KVL * 2, WS_CS = WS_KR + (size_t)M * 64 * 2;
static_assert(WS_CS + (size_t)M * 64 * 4 <= WS_SLOTS && WS_INV + (size_t)16384 * 4 <= WS_WQB, "P2 / P6 small outputs fit in the dead Win_t region");
constexpr size_t DO_Y = 0, DO_QN = (size_t)M * DM * 2, DO_K8 = DO_QN + (size_t)M * 3072;
static_assert(DO_K8 + (size_t)M * 2048 <= (size_t)M * DM * 4, "d_out scratch fits");
constexpr int CW_TMO = 0, CW_BAR = 4096, CW_RANK = 8192;

constexpr int RING_OFF = 0, RING_BYTES = 131072;
constexpr int LDSCTL_OFF = RING_BYTES, MISC_OFF = LDSCTL_OFF + 320;
constexpr int LDS_BYTES = 147456;

#define GAS __attribute__((address_space(1)))
#define LAS __attribute__((address_space(3)))
typedef unsigned short bf16;
typedef unsigned v4u __attribute__((ext_vector_type(4)));
typedef unsigned v2u __attribute__((ext_vector_type(2)));
typedef float f32x4 __attribute__((ext_vector_type(4)));
typedef GAS unsigned gu32;
#define RLX_AGENT __ATOMIC_RELAXED, __HIP_MEMORY_SCOPE_AGENT
#define LDS_WAIT() asm volatile("s_waitcnt lgkmcnt(0)" ::: "memory")
__device__ __forceinline__ unsigned f2bf(float f) { unsigned u = __builtin_bit_cast(unsigned, f); return (u + 0x7fffu + ((u >> 16) & 1u)) >> 16; }
__device__ __forceinline__ unsigned pk2(float lo, float hi) { return f2bf(lo) | (f2bf(hi) << 16); }
__device__ __forceinline__ float bfl(unsigned w) { return __uint_as_float(w << 16); }
__device__ __forceinline__ float bfh(unsigned w) { return __uint_as_float(w & 0xffff0000u); }

#define XB_TMO      128
#define XB_XCNT(j)  (256  + 64 * (j))
#define XB_XSUB(j)  (1280 + 64 * (j))
#define XB_XGEN(j)  (2304 + 64 * (j))
#define XB_TOP      3328
#define XB_TOPGEN   3392
#define XCD_BAR_WORDS 3456
#define XB_SPIN_CAP (1u << 18)
__device__ __forceinline__ unsigned xb_ld(unsigned* p)              { return __hip_atomic_load(p, __ATOMIC_RELAXED, __HIP_MEMORY_SCOPE_AGENT); }
__device__ __forceinline__ unsigned xb_add(unsigned* p, unsigned v) { return __hip_atomic_fetch_add(p, v, __ATOMIC_RELAXED, __HIP_MEMORY_SCOPE_AGENT); }
__device__ __forceinline__ unsigned xb_xcc_id() { return (unsigned)__builtin_amdgcn_s_getreg((3 << 11) | 20) & 0xFu; }
#define XB_SPIN(cond, bar) do { unsigned _sp = 0; while (cond) { __builtin_amdgcn_s_sleep(1); \
    if ((++_sp & 255u) == 0u) { if (xb_ld(&(bar)[XB_TMO])) break; if (_sp > XB_SPIN_CAP) { atomicAdd(&(bar)[XB_TMO], 1u); break; } } } } while (0)
struct XcdBarrier { unsigned* bar; unsigned x; volatile LAS unsigned* st; };
__device__ __forceinline__ XcdBarrier xcd_barrier_post(unsigned* bar, volatile LAS unsigned* st, const int wv) {
    XcdBarrier b; b.bar = bar; b.x = xb_xcc_id(); b.st = st;
    if (wv == 0 && pg8::lane_id() == 0) (void)xb_add(&bar[XB_XCNT(b.x)], 1u);
    return b;
}
__device__ __forceinline__ void xcd_barrier_complete(unsigned* bar, unsigned x, unsigned& nloc, unsigned& nx) {
    const unsigned G = gridDim.x * gridDim.y * gridDim.z;
    unsigned sum, cnt, mine, sp = 0u;
    for (;;) {
        sum = 0u; cnt = 0u; mine = 0u;
#pragma unroll
        for (unsigned j = 0; j < 16; ++j) { const unsigned c = xb_ld(&bar[XB_XCNT(j)]); sum += c; cnt += (c > 0u) ? 1u : 0u; mine = (j == x) ? c : mine; }
        if (sum == G) break;
        __builtin_amdgcn_s_sleep(1);
        if ((++sp & 255u) == 0u) { if (xb_ld(&bar[XB_TMO])) break; if (sp > XB_SPIN_CAP) { atomicAdd(&bar[XB_TMO], 1u); break; } }
    }
    nloc = mine > 0u ? mine : 1u; nx = cnt > 0u ? cnt : 1u;
}
__device__ __forceinline__ void xcd_barrier(const XcdBarrier& b, const int wv) {
    asm volatile("s_waitcnt vmcnt(0)" ::: "memory");
    __syncthreads();
    if (wv == 0 && pg8::lane_id() == 0) {
        unsigned* bar = b.bar;
        __builtin_amdgcn_s_waitcnt(0);
        unsigned nloc = b.st[0], nx = b.st[1];
        if (nloc == 0u) { xcd_barrier_complete(bar, b.x, nloc, nx); b.st[0] = nloc; b.st[1] = nx; }
        const unsigned old = xb_add(&bar[XB_XSUB(b.x)], 1u);
        const unsigned gen = old / nloc;
        if (old + 1u == (gen + 1u) * nloc) {
            __builtin_amdgcn_fence(__ATOMIC_RELEASE, "agent");
            asm volatile("s_waitcnt vmcnt(0)" ::: "memory");
            const unsigned og = xb_add(&bar[XB_TOP], 1u);
            const unsigned tg = og / nx;
            if (og + 1u == (tg + 1u) * nx) xb_add(&bar[XB_TOPGEN], 1u);
            else XB_SPIN(xb_ld(&bar[XB_TOPGEN]) == tg, bar);
            __builtin_amdgcn_fence(__ATOMIC_ACQUIRE, "agent");
            xb_add(&bar[XB_XGEN(b.x)], 1u);
            asm volatile("s_waitcnt vmcnt(0)" ::: "memory");
        } else {
            XB_SPIN(xb_ld(&bar[XB_XGEN(b.x)]) == gen, bar);
            __builtin_amdgcn_fence(__ATOMIC_ACQUIRE, "agent");
            asm volatile("s_waitcnt vmcnt(0)" ::: "memory");
        }
    }
    __syncthreads();
}

__device__ __forceinline__ float wave_sum(float v) {
#pragma unroll
    for (int o = 1; o < 64; o <<= 1) v += __shfl_xor(v, o);
    return v;
}
enum { J_IN = 0, J_QB, J_KVB, J_BR, J_OUT, J_GU, J_DN };
template <int JOB> __device__ __forceinline__ int xmap(int n, int aux) {
    if constexpr (JOB == J_IN) return n;
    else if constexpr (JOB == J_QB) { const int h = n / 192, r = n % 192; return r < 128 ? h * 128 + r : 2048 + (h >> 2) * 256 + ((r - 128) >> 5) * 128 + (h & 3) * 32 + (r & 31); }
    else if constexpr (JOB == J_GU) return (n >> 7) * 256 + aux * 128 + (n & 127);
    else return n;
}
template <int JOB> __device__ __forceinline__ void xpose_tile(const float* W, int Nsrc, int tile, bf16* dst, int ldd, int kofs, int aux, const float* gk, int lane) {
    const int ntn = Nsrc >> 6, k0 = (tile / ntn) << 6, n0 = (tile % ntn) << 6, kb = lane >> 4, nq = lane & 15;
    const GAS f32x4* src = (const GAS f32x4*)(W + (size_t)(k0 + 16 * kb) * Nsrc + n0 + 4 * nq);
    f32x4 v[16];
#pragma unroll
    for (int i = 0; i < 16; ++i) v[i] = src[(size_t)i * (Nsrc >> 2)];
    if (gk) { const GAS f32x4* gp = (const GAS f32x4*)(gk + k0 + 16 * kb);
#pragma unroll
        for (int q = 0; q < 4; ++q) { const f32x4 g4 = gp[q]; v[4 * q] = v[4 * q] * g4.x; v[4 * q + 1] = v[4 * q + 1] * g4.y; v[4 * q + 2] = v[4 * q + 2] * g4.z; v[4 * q + 3] = v[4 * q + 3] * g4.w; } }
    const int nd = xmap<JOB>(n0 + 4 * nq, aux);
    bf16* drow = dst + (size_t)nd * ldd + kofs + k0 + 16 * kb;
#pragma unroll
    for (int j = 0; j < 4; ++j) { v4u a, b;
        a.x = pk2(v[0][j], v[1][j]); a.y = pk2(v[2][j], v[3][j]); a.z = pk2(v[4][j], v[5][j]); a.w = pk2(v[6][j], v[7][j]);
        b.x = pk2(v[8][j], v[9][j]); b.y = pk2(v[10][j], v[11][j]); b.z = pk2(v[12][j], v[13][j]); b.w = pk2(v[14][j], v[15][j]);
        GAS v4u* o = (GAS v4u*)(drow + (size_t)j * ldd); o[0] = a; o[1] = b; }
}
enum { J8_IN = 0, J8_QB, J8_KVB };
template <int JOB8> __device__ __forceinline__ int xmap8(int n) {
    if constexpr (JOB8 == J8_IN) return n >= 7744 ? n - 7744 : 8192 + (n - 6144);
    else if constexpr (JOB8 == J8_QB) return xmap<J_QB>(n, 0);
    else return n;
}
template <int JOB8> __device__ __forceinline__ void xpose_tile_fp8(const float* W, int Nsrc, int k0, int n0, unsigned char* dst, int ldd, float wsc, int lane) {
    const int kb = lane >> 4, nq = lane & 15;
    const GAS f32x4* src = (const GAS f32x4*)(W + (size_t)(k0 + 16 * kb) * Nsrc + n0 + 4 * nq);
    f32x4 v[16];
#pragma unroll
    for (int i = 0; i < 16; ++i) v[i] = src[(size_t)i * (Nsrc >> 2)] * wsc;
    unsigned char* drow = dst + (size_t)xmap8<JOB8>(n0 + 4 * nq) * ldd + k0 + 16 * kb;
#pragma unroll
    for (int j = 0; j < 4; ++j) { v4u a;
        a.x = pg8::pk4_fp8(v[0][j], v[1][j], v[2][j], v[3][j]); a.y = pg8::pk4_fp8(v[4][j], v[5][j], v[6][j], v[7][j]);
        a.z = pg8::pk4_fp8(v[8][j], v[9][j], v[10][j], v[11][j]); a.w = pg8::pk4_fp8(v[12][j], v[13][j], v[14][j], v[15][j]);
        *(GAS v4u*)(drow + (size_t)j * ldd) = a; }
}
template <bool OUTF> __device__ __forceinline__ void rms_row4096(const float* xrow, const float* g, void* orow, int lane) {
    const GAS f32x4* xr = (const GAS f32x4*)xrow + lane;
    f32x4 v[16]; float s = 0.f;
#pragma unroll
    for (int j = 0; j < 16; ++j) { v[j] = xr[64 * j]; s += (v[j].x * v[j].x + v[j].y * v[j].y) + (v[j].z * v[j].z + v[j].w * v[j].w); }
    const float inv = 1.0f / sqrtf(wave_sum(s) * (1.f / 4096.f) + RMS_EPS);
    const GAS f32x4* gr = (const GAS f32x4*)g + lane;
#pragma unroll
    for (int j = 0; j < 16; ++j) { const f32x4 gv = gr[64 * j]; const f32x4 o = v[j] * inv * gv;
        if constexpr (OUTF) ((GAS f32x4*)orow + lane)[64 * j] = o;
        else ((GAS unsigned long long*)orow + lane)[64 * j] = (unsigned long long)pk2(o.x, o.y) | ((unsigned long long)pk2(o.z, o.w) << 32); }
}

struct Args { const float* in[17]; float* out; unsigned char* ws; int ph_lo, ph_hi; };
static_assert(sizeof(Args) == 17 * 8 + 8 + 8 + 8, "no padding in Args");
constexpr int N_PHASES = 11;

__global__ void __launch_bounds__(NWAVES * 64, 2) mega_fwd(Args args) {
    extern __shared__ __attribute__((aligned(16))) unsigned char lds[];
    LAS unsigned char* L = (LAS unsigned char*)lds;
    volatile LAS unsigned* MISC = (volatile LAS unsigned*)(L + MISC_OFF);
    const int tid = threadIdx.x, lane = tid & 63, wave = __builtin_amdgcn_readfirstlane(tid >> 6);
    const int G = gridDim.x; const int bx = blockIdx.x; const int vcu = (G % 8 == 0) ? (bx % 8) * (G / 8) + bx / 8 : bx;
    unsigned char* ws = args.ws;
    gu32* ctl = (gu32*)(ws + WS_CTL);
    const float* x = args.in[0]; const int* positions = (const int*)args.in[1]; const float* g_mix = args.in[2]; const float* w_in = args.in[3];
    const float* b_gate = args.in[4]; const float* conv_w = args.in[5]; const float* g_q_a = args.in[6]; const float* w_q_b = args.in[7];
    const float* g_kv_a = args.in[8]; const float* w_kv_b = args.in[9]; const float* w_branch = args.in[10]; const float* w_out = args.in[11];
    const float* g_ffn = args.in[12]; const float* w_ffn_gate = args.in[13]; const float* w_ffn_up = args.in[14]; const float* w_ffn_down = args.in[15];
    const float* g_final = args.in[16];
    float* out = args.out; unsigned char* ob = (unsigned char*)args.out;
    unsigned char* Wg8_t = ws + WS_WG8; unsigned char* H8 = ws + WS_H8;
    bf16* Win_t = (bf16*)(ws + WS_WIN + 64 * MiB);
    bf16* Wbr_t = (bf16*)(ws + WS_WBR);
    bf16* Wout_t = (bf16*)(ws + WS_WOUT); bf16* Wgu_t = (bf16*)(ws + WS_WGU); bf16* Wdn_t = (bf16*)(ws + WS_WDN);
    bf16* RA = (bf16*)(ws + WS_RA); bf16* zc = (bf16*)(ws + WS_ZC); bf16* zs = (bf16*)(ws + WS_ZS); bf16* zr = (bf16*)(ws + WS_ZR); bf16* zg = (bf16*)(ws + WS_ZG);
    unsigned char* V8T = ws + WS_KV; bf16* H2 = (bf16*)(ws + WS_H2); bf16* ACT = (bf16*)(ws + WS_ACT);
    unsigned char* QN8 = ws + WS_QN; unsigned char* KVN8 = ws + WS_KVN; float* CS = (float*)(ws + WS_CS);
    unsigned char* Wqb8_t = ws + WS_WQB; unsigned char* Wkvb8_t = ws + WS_WKVB;
    float* SLOTS = (float*)(ws + WS_SLOTS); float* INV = (float*)(ws + WS_INV);
    bf16* Y = (bf16*)(ob + DO_Y); unsigned char* Q8 = ob + DO_QN; unsigned char* K8n = ob + DO_K8; unsigned char* KR8 = ws + WS_KR;

    for (int u = tid; u < (LDS_BYTES - LDSCTL_OFF) / 4; u += NWAVES * 64) ((LAS unsigned*)(L + LDSCTL_OFF))[u] = 0u;
    __syncthreads();
    XcdBarrier bar; bar.bar = (unsigned*)(ctl + CW_BAR); bar.x = 0; bar.st = nullptr;
    if (!MK_PER_PHASE) bar = xcd_barrier_post((unsigned*)(ctl + CW_BAR), MISC + 8, wave);
    const int lo = args.ph_lo, hi = args.ph_hi;
#define IN(k) (lo <= (k) && (k) < hi)
#define SEAM(k) do { if (IN(k) && IN((k) + 1)) xcd_barrier(bar, wave); } while (0)
    const int gw = vcu * NWAVES + wave, NGW = G * NWAVES;
    if (!MK_PER_PHASE && tid == 0) { const unsigned xcc_ = xb_xcc_id(); MISC[16] = xcc_; MISC[17] = __hip_atomic_fetch_add((unsigned*)(ctl + CW_RANK + 64 * xcc_), 1u, RLX_AGENT); }

    if (IN(0)) for (int rep_ = 0; rep_ < DUP(0); ++rep_) {
        int tz_ = pg8::lane_id(); asm volatile("" : "+v"(tz_)); const int lane = tz_;
        constexpr int T_IN = (DM / 64) * (IN_COLS / 64), T_BR = (CONV / 64) * (DM / 64), T_G = (DM / 64) * (DFF / 64);
        constexpr int T_QB = (QL / 64) * (NQ / 64), T_KVB = (KVL / 64) * (NKV / 64), T_OUT = (DM / 64) * (DM / 64), T_DN = (DFF / 64) * (DM / 64);
        constexpr int NT0 = T_IN + 2 * T_G + T_QB + T_KVB;
        for (int it = gw; it < NT0; it += NGW) {
            int r = it;
            if (r < T_IN) { const int ntn_ = IN_COLS >> 6, n0_ = (r % ntn_) << 6;
                if (n0_ >= 6144) xpose_tile_fp8<J8_IN>(w_in, IN_COLS, (r / ntn_) << 6, n0_, Wg8_t, DM, 64.0f, lane);
                else xpose_tile<J_IN>(w_in, IN_COLS, r, Win_t, DM, 0, 0, nullptr, lane);
                continue; } r -= T_IN;
            if (r < 2 * T_G) { const int up = r / T_G; r -= up * T_G; xpose_tile<J_GU>(up ? w_ffn_up : w_ffn_gate, DFF, r, Wgu_t, DM, 0, up, g_ffn, lane); continue; } r -= 2 * T_G;
            if (r < T_QB) { const int ntn_ = NQ >> 6; xpose_tile_fp8<J8_QB>(w_q_b, NQ, (r / ntn_) << 6, (r % ntn_) << 6, Wqb8_t, QL, 32.0f, lane); continue; } r -= T_QB;
            { const int ntn_ = NKV >> 6; xpose_tile_fp8<J8_KVB>(w_kv_b, NKV, (r / ntn_) << 6, (r % ntn_) << 6, Wkvb8_t, KVL, 16.0f, lane); }
        }
        for (int rr = gw; rr < 192; rr += NGW) { GAS v4u* p = (GAS v4u*)(Wg8_t + (size_t)(9792 + rr) * DM) + lane;
#pragma unroll
            for (int j = 0; j < 4; ++j) p[64 * j] = (v4u){0u, 0u, 0u, 0u}; }
        for (int m = gw; m < M; m += NGW) {
            const GAS f32x4* xr = (const GAS f32x4*)(x + (size_t)m * DM) + lane; f32x4 v[16]; float s = 0.f;
#pragma unroll
            for (int j = 0; j < 16; ++j) { v[j] = xr[64 * j]; s += (v[j].x * v[j].x + v[j].y * v[j].y) + (v[j].z * v[j].z + v[j].w * v[j].w); }
            const float inv = 1.0f / sqrtf(wave_sum(s) * (1.f / 4096.f) + RMS_EPS);
            const GAS f32x4* gr = (const GAS f32x4*)g_mix + lane;
            GAS unsigned long long* ob_ = (GAS unsigned long long*)(RA + (size_t)m * DM) + lane; GAS unsigned* o8_ = (GAS unsigned*)(H8 + (size_t)m * DM) + lane;
#pragma unroll
            for (int j = 0; j < 16; ++j) { const f32x4 o = v[j] * inv * gr[64 * j];
                ob_[64 * j] = (unsigned long long)pk2(o.x, o.y) | ((unsigned long long)pk2(o.z, o.w) << 32); o8_[64 * j] = pg8::pk4_fp8(o.x, o.y, o.z, o.w); } }
    }
    SEAM(0);
    int cx = bx, vcx = vcu;
    if (!MK_PER_PHASE && lo == 0 && hi > 1) {
        bool uni = (G % 8 == 0);
        for (int j = 0; j < 16; ++j) { const unsigned cnt_ = __hip_atomic_load((unsigned*)(ctl + CW_BAR) + XB_XCNT(j), RLX_AGENT); uni = uni && (j < 8 ? cnt_ == (unsigned)(G / 8) : cnt_ == 0u); }
        if (uni) { const int xcc_ = (int)MISC[16], rk_ = (int)MISC[17]; cx = rk_ * 8 + xcc_; vcx = xcc_ * (G / 8) + rk_; }
    }
    cx = __builtin_amdgcn_readfirstlane(cx); vcx = __builtin_amdgcn_readfirstlane(vcx);

    if (IN(1)) for (int rep_ = 0; rep_ < DUP(1); ++rep_) {
        { pg8::Gemm g{(const bf16*)H8, (const bf16*)Wg8_t, M, 8192, DM / 2, DM / 2, DM / 2}; pg8::StaticOrder S; S.init(M, 8192, G, cx);
          pg8::EpiG8 E{(unsigned char*)zg, 1.0f / 64.0f};
          pg8::gemm_phase<pg8::EpiG8, pg8::StaticOrder, true, true, false, true, false, true>(L + RING_OFF, g, S, E, wave); }
        { pg8::Gemm g{(const bf16*)H8, (const bf16*)(Wg8_t + (size_t)8192 * DM), M, 1792, DM / 2, DM / 2, DM / 2}; pg8::StaticOrder S; S.init(M, 1792, G, cx);
          pg8::EpiZ8 E{zg, zs, zr, 1.0f / 64.0f};
          pg8::gemm_phase<pg8::EpiZ8, pg8::StaticOrder, true, true, false, true, false, true>(L + RING_OFF, g, S, E, wave); }
        { pg8::Gemm g{RA, Win_t, M, 6144, DM, DM, DM}; pg8::StaticOrder S; S.init(M, 6144, G, cx);
          pg8::EpiBf16 E{zc, 6144, 1.0f};
          pg8::gemm_phase<pg8::EpiBf16, pg8::StaticOrder, true, true>(L + RING_OFF, g, S, E, wave); }
        { constexpr int T_BR = (CONV / 64) * (DM / 64), T_OUT = (DM / 64) * (DM / 64); const int rem = ((M / 256) * (1792 / 256)) % G, first = rem, nidle = G - first;
          int tz = pg8::lane_id(); asm volatile("" : "+v"(tz)); const int lane = tz;
          if (cx >= first) for (int it = (cx - first) * NWAVES + wave; it < 2 * T_BR + T_OUT; it += nidle * NWAVES) { int r = it;
              if (r < T_BR) { xpose_tile<J_BR>(w_branch, DM, r, Wbr_t, DM, 0, 0, nullptr, lane); continue; } r -= T_BR;
              if (r < T_BR) { xpose_tile_fp8<J8_KVB>(w_branch + (size_t)CONV * DM, DM, (r / (DM >> 6)) << 6, (r % (DM >> 6)) << 6, (unsigned char*)Wbr_t + 4096, DM * 2, 32.0f, lane); continue; } r -= T_BR;
              xpose_tile<J_OUT>(w_out, DM, r, Wout_t, DM, 0, 0, nullptr, lane); } }
    }
    SEAM(1);

    if (IN(2)) for (int rep_ = 0; rep_ < DUP(2); ++rep_) {
        int tz_ = pg8::lane_id(); asm volatile("" : "+v"(tz_)); const int lane = tz_;
        for (int m = gw; m < M; m += NGW) {
            const bf16* zrow = zs + (size_t)m * 1536;
            const v4u q0 = *(const GAS v4u*)(zrow + lane * 8), q1 = *(const GAS v4u*)(zrow + 512 + lane * 8), k0 = *(const GAS v4u*)(zrow + 1024 + lane * 8);
            const unsigned short rraw = zr[(size_t)m * 256 + lane];
            const int pos = positions[m];
            float qa[16], ka[8];
            qa[0] = bfl(q0.x); qa[1] = bfh(q0.x); qa[2] = bfl(q0.y); qa[3] = bfh(q0.y); qa[4] = bfl(q0.z); qa[5] = bfh(q0.z); qa[6] = bfl(q0.w); qa[7] = bfh(q0.w);
            qa[8] = bfl(q1.x); qa[9] = bfh(q1.x); qa[10] = bfl(q1.y); qa[11] = bfh(q1.y); qa[12] = bfl(q1.z); qa[13] = bfh(q1.z); qa[14] = bfl(q1.w); qa[15] = bfh(q1.w);
            ka[0] = bfl(k0.x); ka[1] = bfh(k0.x); ka[2] = bfl(k0.y); ka[3] = bfh(k0.y); ka[4] = bfl(k0.z); ka[5] = bfh(k0.z); ka[6] = bfl(k0.w); ka[7] = bfh(k0.w);
            float sq = 0.f, sk = 0.f;
#pragma unroll
            for (int j = 0; j < 16; ++j) sq += qa[j] * qa[j];
#pragma unroll
            for (int j = 0; j < 8; ++j) sk += ka[j] * ka[j];
            const float iq = 1.0f / sqrtf(wave_sum(sq) * (1.f / 1024.f) + RMS_EPS), ik = 1.0f / sqrtf(wave_sum(sk) * (1.f / 512.f) + RMS_EPS);
            const f32x4 ga0 = *(const GAS f32x4*)(g_q_a + lane * 8), ga1 = *(const GAS f32x4*)(g_q_a + lane * 8 + 4), gb0 = *(const GAS f32x4*)(g_q_a + 512 + lane * 8), gb1 = *(const GAS f32x4*)(g_q_a + 512 + lane * 8 + 4);
            const f32x4 gk0 = *(const GAS f32x4*)(g_kv_a + lane * 8), gk1 = *(const GAS f32x4*)(g_kv_a + lane * 8 + 4);
            v2u o;
            o.x = pg8::pk4_fp8(qa[0] * iq * ga0.x, qa[1] * iq * ga0.y, qa[2] * iq * ga0.z, qa[3] * iq * ga0.w); o.y = pg8::pk4_fp8(qa[4] * iq * ga1.x, qa[5] * iq * ga1.y, qa[6] * iq * ga1.z, qa[7] * iq * ga1.w);
            *(GAS v2u*)(QN8 + (size_t)m * QL + lane * 8) = o;
            o.x = pg8::pk4_fp8(qa[8] * iq * gb0.x, qa[9] * iq * gb0.y, qa[10] * iq * gb0.z, qa[11] * iq * gb0.w); o.y = pg8::pk4_fp8(qa[12] * iq * gb1.x, qa[13] * iq * gb1.y, qa[14] * iq * gb1.z, qa[15] * iq * gb1.w);
            *(GAS v2u*)(QN8 + (size_t)m * QL + 512 + lane * 8) = o;
            o.x = pg8::pk4_fp8(ka[0] * ik * gk0.x, ka[1] * ik * gk0.y, ka[2] * ik * gk0.z, ka[3] * ik * gk0.w); o.y = pg8::pk4_fp8(ka[4] * ik * gk1.x, ka[5] * ik * gk1.y, ka[6] * ik * gk1.z, ka[7] * ik * gk1.w);
            *(GAS v2u*)(KVN8 + (size_t)m * KVL + lane * 8) = o;
            const int i = lane & 31;
            const float invf = powf(10000.0f, -(float)(2 * i) * (1.0f / 64.0f));
            const float ang = (float)pos * invf; float sn, cn; sincosf(ang, &sn, &cn);
            const float mine = __uint_as_float(((unsigned)rraw) << 16), other = __shfl_xor(mine, 32);
            const float rot = lane < 32 ? (mine * cn - other * sn) : (other * sn + mine * cn);
            KR8[(size_t)m * 64 + lane] = (unsigned char)(__builtin_amdgcn_cvt_pk_fp8_f32(rot, 0.f, 0, false) & 0xff);
            if (lane < 32) { float2 c2; c2.x = cn; c2.y = sn; *(float2*)(CS + (size_t)m * 64 + 2 * i) = c2; }
        }
        for (int it = gw; it < (M / 32) * 4; it += NGW) {
            const int r0 = (it >> 2) * 32, c0 = (it & 3) * 512 + lane * 8;
            float w0[8], w1[8], w2[8];
#pragma unroll
            for (int j = 0; j < 8; ++j) { w0[j] = conv_w[c0 + j]; w1[j] = conv_w[CONV + c0 + j]; w2[j] = conv_w[2 * CONV + c0 + j]; }
            float up[8], uc[8], un[8];
#define CONV_U(dst, row) do { const v4u cc = *(const GAS v4u*)(zc + (size_t)(row) * 6144 + 2048 + c0), ch = *(const GAS v4u*)(zc + (size_t)(row) * 6144 + 4096 + c0); \
            dst[0] = bfl(cc.x) * bfl(ch.x); dst[1] = bfh(cc.x) * bfh(ch.x); dst[2] = bfl(cc.y) * bfl(ch.y); dst[3] = bfh(cc.y) * bfh(ch.y); \
            dst[4] = bfl(cc.z) * bfl(ch.z); dst[5] = bfh(cc.z) * bfh(ch.z); dst[6] = bfl(cc.w) * bfl(ch.w); dst[7] = bfh(cc.w) * bfh(ch.w); } while (0)
            if ((r0 & (SEQ - 1)) != 0) CONV_U(up, r0 - 1); else {
#pragma unroll
                for (int j = 0; j < 8; ++j) up[j] = 0.f; }
            CONV_U(uc, r0);
            const bool tail_ok = ((r0 + 32) & (SEQ - 1)) != 0;
#pragma unroll 4
            for (int r = r0; r < r0 + 32; ++r) {
                if (r + 1 < r0 + 32 || tail_ok) CONV_U(un, r + 1); else {
#pragma unroll
                    for (int j = 0; j < 8; ++j) un[j] = 0.f; }
                const v4u cb = *(const GAS v4u*)(zc + (size_t)r * 6144 + c0);
                float yv[8];
#pragma unroll
                for (int j = 0; j < 8; ++j) yv[j] = w0[j] * up[j] + w1[j] * uc[j] + w2[j] * un[j];
                v4u o; o.x = pk2(bfl(cb.x) * yv[0], bfh(cb.x) * yv[1]); o.y = pk2(bfl(cb.y) * yv[2], bfh(cb.y) * yv[3]); o.z = pk2(bfl(cb.z) * yv[4], bfh(cb.z) * yv[5]); o.w = pk2(bfl(cb.w) * yv[6], bfh(cb.w) * yv[7]);
                *(GAS v4u*)(Y + (size_t)r * DM + c0) = o;
#pragma unroll
                for (int j = 0; j < 8; ++j) { up[j] = uc[j]; uc[j] = un[j]; }
            }
#undef CONV_U
        }
    }
    SEAM(2);

    if (IN(3)) for (int rep_ = 0; rep_ < DUP(3); ++rep_) {
        { pg8::Gemm g{(const bf16*)QN8, (const bf16*)Wqb8_t, M, NQ, QL / 2, QL / 2, QL / 2}; pg8::StaticOrder S; S.init(M, NQ, G, cx);
          pg8::EpiQ E{Q8, CS, mla::SCALE * 1.4426950408889634f / 32.0f};
          pg8::gemm_phase<pg8::EpiQ, pg8::StaticOrder, true, true, false, true>(L + RING_OFF, g, S, E, wave); }
        { pg8::Gemm g{(const bf16*)KVN8, (const bf16*)Wkvb8_t, M, NKV, KVL / 2, KVL / 2, KVL / 2}; pg8::StaticOrder S; S.init(M, NKV, G, cx);
          pg8::EpiKV E{K8n, V8T, 1.0f / 16.0f};
          pg8::gemm_phase<pg8::EpiKV, pg8::StaticOrder, true, true, false, true>(L + RING_OFF, g, S, E, wave); }
    }
    SEAM(3);

    if (IN(4)) for (int rep_ = 0; rep_ < DUP(4); ++rep_) {
        for (int i = 0; ; ++i) {
            const int u = i * G + vcx; if (u >= BATCH * NH * (SEQ / 256)) break;
            const int bh = u >> 4, qb = u & 15, b = bh >> 4, h = bh & 15;
            const size_t q0 = (size_t)b * SEQ + (size_t)qb * 256, kbase = (size_t)b * SEQ;
            mla::attn_unit(Q8 + q0 * 3072 + h * 192, K8n + kbase * 2048 + h * 128, KR8 + kbase * 64, V8T + (size_t)bh * (64 * 8192),
                           (unsigned char*)Y + q0 * (DM * 2) + 4096 + h * 128, SEQ, (char*)lds + RING_OFF, wave);
            __syncthreads();
        }
    }
    SEAM(4);

    if (IN(5)) for (int rep_ = 0; rep_ < DUP(5); ++rep_) {
        pg8::Gemm g{Y, Wbr_t, M, DM, 3072, DM, DM}; pg8::StaticOrder S; S.init(M, DM, G, cx);
        pg8::EpiGate E{(const unsigned char*)zg, b_gate, RA};
        pg8::gemm_phase<pg8::EpiGate, pg8::StaticOrder, true, true, false, false, true, true>(L + RING_OFF, g, S, E, wave);
    }
    SEAM(5);

    if (IN(6)) for (int rep_ = 0; rep_ < DUP(6); ++rep_) {
        pg8::Gemm g{RA, Wout_t, M, DM, DM, DM, DM}; pg8::StaticOrder S; S.init(M, DM, G, cx);
        pg8::EpiRes1 E{x, H2, SLOTS, DM};
        pg8::gemm_phase<pg8::EpiRes1, pg8::StaticOrder, true, true>(L + RING_OFF, g, S, E, wave);
    }
    SEAM(6);

    if (IN(7)) for (int rep_ = 0; rep_ < DUP(7); ++rep_) {
        int tz_ = pg8::lane_id(); asm volatile("" : "+v"(tz_)); const int lane = tz_;
        for (int m = gw; m < M; m += NGW) { const float s = wave_sum(SLOTS[(size_t)m * 64 + lane]); if (lane == 0) INV[m] = 1.0f / sqrtf(s * (1.f / 4096.f) + RMS_EPS); }
    }
    SEAM(7);

    if (IN(8)) for (int rep_ = 0; rep_ < DUP(8); ++rep_) {
        pg8::Gemm g{H2, Wgu_t, M, NGU, DM, DM, DM}; pg8::StaticOrder S; S.init(M, NGU, G, cx);
        pg8::EpiSwiGLU E{ACT, DFF, INV};
        pg8::gemm_phase<pg8::EpiSwiGLU, pg8::StaticOrder, true, true>(L + RING_OFF, g, S, E, wave);
        { constexpr int T_DN = (DFF / 64) * (DM / 64); const int rem = S.nwg % G, first = rem, nidle = G - first;
          int tz_ = pg8::lane_id(); asm volatile("" : "+v"(tz_)); const int lane = tz_;
          if (cx >= first) for (int it = (cx - first) * NWAVES + wave; it < T_DN; it += nidle * NWAVES) xpose_tile<J_DN>(w_ffn_down, DM, it, Wdn_t, DFF, 0, 0, nullptr, lane); }
    }
    SEAM(8);

    if (IN(9)) for (int rep_ = 0; rep_ < DUP(9); ++rep_) {
        pg8::Gemm g{ACT, Wdn_t, M, DM, DFF, DFF, DFF}; pg8::StaticOrder S; S.init(M, DM, G, cx, 4);
        pg8::EpiResB E{H2, DM};
        pg8::gemm_phase<pg8::EpiResB, pg8::StaticOrder, true, true>(L + RING_OFF, g, S, E, wave);
    }
    SEAM(9);

    if (IN(10)) for (int rep_ = 0; rep_ < DUP(10); ++rep_) {
        int tz_ = pg8::lane_id(); asm volatile("" : "+v"(tz_)); const int lane = tz_;
        for (int m = gw; m < M; m += NGW) {
            const GAS v4u* xr = (const GAS v4u*)(H2 + (size_t)m * DM) + lane; v4u v[8]; float s = 0.f;
#pragma unroll
            for (int j = 0; j < 8; ++j) { v[j] = xr[64 * j];
                s += (bfl(v[j].x) * bfl(v[j].x) + bfh(v[j].x) * bfh(v[j].x)) + (bfl(v[j].y) * bfl(v[j].y) + bfh(v[j].y) * bfh(v[j].y))
                   + (bfl(v[j].z) * bfl(v[j].z) + bfh(v[j].z) * bfh(v[j].z)) + (bfl(v[j].w) * bfl(v[j].w) + bfh(v[j].w) * bfh(v[j].w)); }
            const float inv = 1.0f / sqrtf(wave_sum(s) * (1.f / 4096.f) + RMS_EPS);
            const GAS f32x4* gr = (const GAS f32x4*)g_final + 2 * lane; GAS f32x4* orow = (GAS f32x4*)(out + (size_t)m * DM) + 2 * lane;
#pragma unroll
            for (int j = 0; j < 8; ++j) { const f32x4 g0 = gr[128 * j], g1 = gr[128 * j + 1];
                orow[128 * j] = (f32x4){bfl(v[j].x) * inv * g0.x, bfh(v[j].x) * inv * g0.y, bfl(v[j].y) * inv * g0.z, bfh(v[j].y) * inv * g0.w};
                orow[128 * j + 1] = (f32x4){bfl(v[j].z) * inv * g1.x, bfh(v[j].z) * inv * g1.y, bfl(v[j].w) * inv * g1.z, bfh(v[j].w) * inv * g1.w}; }
        }
    }
#undef IN
#undef SEAM
}

extern "C" void kernel_launch(void* const* d_in, const int* in_sizes, int n_in, void* d_out, int out_size, void* d_ws, size_t ws_size, hipStream_t stream) {
    static int grid = 0;
    if (grid == 0) {
        if (n_in != 17 || in_sizes[0] != M * DM || out_size != M * DM || ws_size < WS_END) { fprintf(stderr, "kernel_launch: shape/workspace mismatch (n_in %d, in0 %d, out %d, ws %zu, need %zu)\n", n_in, n_in > 0 ? in_sizes[0] : -1, out_size, ws_size, (size_t)WS_END); grid = -1; return; }
        int dev = 0, cus = 0, per_cu = 0;
        if (hipGetDevice(&dev) != hipSuccess || hipDeviceGetAttribute(&cus, hipDeviceAttributeMultiprocessorCount, dev) != hipSuccess) { grid = -1; return; }
        if (hipFuncSetAttribute((const void*)mega_fwd, hipFuncAttributeMaxDynamicSharedMemorySize, LDS_BYTES) != hipSuccess) { fprintf(stderr, "kernel_launch: hipFuncSetAttribute failed\n"); grid = -1; return; }
        if (hipOccupancyMaxActiveBlocksPerMultiprocessor(&per_cu, (const void*)mega_fwd, NWAVES * 64, LDS_BYTES) != hipSuccess || per_cu < 1)
            fprintf(stderr, "kernel_launch: note: occupancy query reports %d workgroups per CU\n", per_cu);
        (void)hipGetLastError();
        grid = cus;
    }
    if (grid < 0) return;
    if (hipMemsetAsync((char*)d_ws + WS_CTL, 0, CTL_ZERO_BYTES, stream) != hipSuccess) return;
    Args a{};
    for (int i = 0; i < 17; ++i) a.in[i] = (const float*)d_in[i];
    a.out = (float*)d_out; a.ws = (unsigned char*)d_ws;
#if MK_PER_PHASE
    for (int p = 0; p < N_PHASES; ++p) { a.ph_lo = p; a.ph_hi = p + 1; hipLaunchKernelGGL(mega_fwd, dim3(grid), dim3(NWAVES * 64), LDS_BYTES, stream, a); }
#else
    a.ph_lo = 0; a.ph_hi = N_PHASES;
    hipLaunchKernelGGL(mega_fwd, dim3(grid), dim3(NWAVES * 64), LDS_BYTES, stream, a);
#endif
    const hipError_t le = hipPeekAtLastError();
    if (le != hipSuccess) fprintf(stderr, "kernel_launch: launch failed: %s\n", hipGetErrorName(le));
}
```
